# Optimizing an MI355X kernel written in HIP

```python
import math
import jax
import jax.numpy as jnp
from jax import lax
import numpy as np

D_MODEL = 1024
BATCH = 2
SEQ = 8192
DEPTH = 2

HEAD_DIM = 64
GROUP_WIDTH = D_MODEL // 4
MIX_WIDTH = 4 * GROUP_WIDTH
ML_HEADS = GROUP_WIDTH // HEAD_DIM
ML_CHUNK = 64
POOL_WINDOWS = (2, 4, 8, 16)
POOL_GROUPS = len(POOL_WINDOWS)
POOL_CH = GROUP_WIDTH // POOL_GROUPS
DIFF_HEADS = GROUP_WIDTH // HEAD_DIM
DIFF_QK_DIM = HEAD_DIM // 2
GQA_Q_HEADS = GROUP_WIDTH // HEAD_DIM
GQA_KV_HEADS = GQA_Q_HEADS // 2
GQA_GROUP = GQA_Q_HEADS // GQA_KV_HEADS
GRID_W = 64
ROPE_THETA = 10000.0
Q_BLOCK = 128
MEM_LEN = 256
CROSS_HEADS = 4
CROSS_HEAD_DIM = D_MODEL // CROSS_HEADS
D_FF = 256 * math.ceil(8 * D_MODEL / 3 / 256)
CONV_W = 3
EPS = 1e-6
IN_SIZES = (GROUP_WIDTH, GROUP_WIDTH, GROUP_WIDTH, GROUP_WIDTH, 4 * ML_HEADS,
            GROUP_WIDTH,
            DIFF_HEADS * 2 * DIFF_QK_DIM, DIFF_HEADS * 2 * DIFF_QK_DIM, DIFF_HEADS * HEAD_DIM,
            GQA_Q_HEADS * HEAD_DIM, GQA_KV_HEADS * HEAD_DIM, GQA_KV_HEADS * HEAD_DIM)
D_IN = sum(IN_SIZES)

kernel_name = 'hybrid_parallel_head_encoder'


def rms_norm(x, g):
    x32 = x.astype(jnp.float32)
    y = x32 * lax.rsqrt(jnp.mean(x32 * x32, axis=-1, keepdims=True) + EPS)
    return (y * g.astype(jnp.float32)).astype(x.dtype)


def rope_cos_sin(pos, dim):
    inv = ROPE_THETA ** (-jnp.arange(0, dim, 2, dtype=jnp.float32) / dim)
    ang = pos.astype(jnp.float32)[:, None] * inv[None, :]
    return jnp.cos(ang), jnp.sin(ang)


def apply_rope(x, cos, sin):
    d2 = x.shape[-1] // 2
    bshape = (cos.shape[0],) + (1,) * (x.ndim - 3) + (cos.shape[1],)
    c = cos.reshape(bshape).astype(x.dtype)
    s = sin.reshape(bshape).astype(x.dtype)
    x1, x2 = x[..., :d2], x[..., d2:]
    return jnp.concatenate([x1 * c - x2 * s, x2 * c + x1 * s], axis=-1)


def sweep_query_blocks(fn, q):
    B, S = q.shape[:2]
    nb = S // Q_BLOCK
    qb = jnp.moveaxis(q.reshape((B, nb, Q_BLOCK) + q.shape[2:]), 1, 0)
    out = lax.map(fn, qb)
    return jnp.moveaxis(out, 0, 1).reshape((B, S) + out.shape[3:])


def mlstm_chunkwise(q, k, v, li, lf):
    B, H, S, d = q.shape
    L = ML_CHUNK
    nc = S // L
    q = q.reshape(B, H, nc, L, d)
    k = k.reshape(B, H, nc, L, d)
    v = v.reshape(B, H, nc, L, d)
    li = li.reshape(B, H, nc, L)
    b = jnp.cumsum(lf.reshape(B, H, nc, L), axis=-1)
    g = b[..., -1]
    a = g[..., None] - b + li
    m_loc = jnp.max(a, axis=-1)
    w = jnp.exp(a - m_loc[..., None])
    C_loc = jnp.einsum('bhcl,bhcld,bhcle->bhcde', w, k, v)
    n_loc = jnp.einsum('bhcl,bhcld->bhcd', w, k)

    def step(carry, inp):
        C, n, m = carry
        g_c, m_l, C_l, n_l = inp
        m_new = jnp.maximum(g_c + m, m_l)
        f_old = jnp.exp(g_c + m - m_new)
        f_loc = jnp.exp(m_l - m_new)
        C_new = f_old[..., None, None] * C + f_loc[..., None, None] * C_l
        n_new = f_old[..., None] * n + f_loc[..., None] * n_l
        return (C_new, n_new, m_new), (C, n, m)

    init = (jnp.zeros((B, H, d, d), jnp.float32), jnp.zeros((B, H, d), jnp.float32),
            jnp.zeros((B, H), jnp.float32))
    xs = (jnp.moveaxis(g, 2, 0), jnp.moveaxis(m_loc, 2, 0),
          jnp.moveaxis(C_loc, 2, 0), jnp.moveaxis(n_loc, 2, 0))
    _, (C_prev, n_prev, m_prev) = lax.scan(step, init, xs)
    C_prev = jnp.moveaxis(C_prev, 0, 2)
    n_prev = jnp.moveaxis(n_prev, 0, 2)
    m_prev = jnp.moveaxis(m_prev, 0, 2)

    lower = jnp.tril(jnp.ones((L, L), dtype=bool))
    dlog = jnp.where(lower, b[..., :, None] - b[..., None, :] + li[..., None, :], -jnp.inf)
    e = b + m_prev[..., None]
    m_t = jnp.maximum(e, jnp.max(dlog, axis=-1))
    wts = jnp.exp(dlog - m_t[..., None]) * jnp.einsum('bhctd,bhcsd->bhcts', q, k)
    s_inter = jnp.exp(e - m_t)
    num = (jnp.einsum('bhcts,bhcsd->bhctd', wts, v)
           + s_inter[..., None] * jnp.einsum('bhctd,bhcde->bhcte', q, C_prev))
    den = jnp.sum(wts, axis=-1) + s_inter * jnp.einsum('bhctd,bhcd->bhct', q, n_prev)
    h = num / jnp.maximum(jnp.abs(den), jnp.exp(-m_t))[..., None]
    return h.reshape(B, H, S, d)


def mlstm_mixer(q, k, v, o, gates, b_i, b_f, g_norm):
    B, S, _ = q.shape
    f32 = jnp.float32
    heads = lambda z: z.astype(f32).reshape(B, S, ML_HEADS, HEAD_DIM).transpose(0, 2, 1, 3)
    qh, kh, vh = heads(q), heads(k) * (HEAD_DIM ** -0.5), heads(v)
    gt = gates.astype(f32).reshape(B, S, 4, ML_HEADS)
    bi = b_i.astype(f32)
    bf = b_f.astype(f32)
    li_f = (gt[:, :, 0] + bi[0]).transpose(0, 2, 1)
    lf_f = jax.nn.log_sigmoid(gt[:, :, 1] + bf[0]).transpose(0, 2, 1)
    li_b = (gt[:, :, 2] + bi[1]).transpose(0, 2, 1)
    lf_b = jax.nn.log_sigmoid(gt[:, :, 3] + bf[1]).transpose(0, 2, 1)
    h_f = mlstm_chunkwise(qh, kh, vh, li_f, lf_f)
    flip = lambda z: jnp.flip(z, axis=2)
    h_b = flip(mlstm_chunkwise(flip(qh), flip(kh), flip(vh), flip(li_b), flip(lf_b)))
    h = (h_f + h_b).transpose(0, 2, 1, 3)
    h = rms_norm(h, g_norm.reshape(ML_HEADS, HEAD_DIM))
    y = h.reshape(B, S, GROUP_WIDTH) * jax.nn.sigmoid(o.astype(f32))
    return y.astype(o.dtype)


def pool_mixer(u, w, scale):
    B, S, _ = u.shape
    ug = u.astype(jnp.float32).reshape(B, S, POOL_GROUPS, POOL_CH)
    cs = jnp.concatenate([jnp.zeros((B, 1, POOL_GROUPS, POOL_CH), jnp.float32),
                          jnp.cumsum(ug, axis=1)], axis=1)
    t = jnp.arange(S)
    outs = []
    for gi, win in enumerate(POOL_WINDOWS):
        lo = jnp.clip(t - win // 2, 0, S - 1)
        hi = jnp.clip(t - win // 2 + win - 1, 0, S - 1)
        cs_g = cs[:, :, gi]
        total = cs_g[:, hi + 1] - cs_g[:, lo]
        cnt = (hi - lo + 1).astype(jnp.float32)[None, :, None]
        outs.append(total / cnt - ug[:, :, gi])
    pooled = jnp.stack(outs, axis=2)
    y = jnp.einsum('bsgc,gce->bsge', pooled, w.astype(jnp.float32))
    return (y.reshape(B, S, GROUP_WIDTH) * scale.astype(jnp.float32)).astype(u.dtype)


def diff_attention(q, k, v, g_q, g_k, lam_params, g_sub, cos, sin, lam_init):
    B, S, _ = q.shape
    q = apply_rope(rms_norm(q.reshape(B, S, DIFF_HEADS, 2, DIFF_QK_DIM), g_q), cos, sin)
    k = apply_rope(rms_norm(k.reshape(B, S, DIFF_HEADS, 2, DIFF_QK_DIM), g_k), cos, sin)
    v = v.reshape(B, S, DIFF_HEADS, HEAD_DIM)
    lp = lam_params.astype(jnp.float32)
    lam = jnp.exp(jnp.sum(lp[0] * lp[1])) - jnp.exp(jnp.sum(lp[2] * lp[3])) + lam_init
    scale = DIFF_QK_DIM ** -0.5

    def block(qb):
        s = jnp.einsum('bqhcd,bshcd->bhcqs', qb, k).astype(jnp.float32) * scale
        p = jax.nn.softmax(s, axis=-1)
        pd = p[:, :, 0] - lam * p[:, :, 1]
        return jnp.einsum('bhqs,bshd->bqhd', pd.astype(v.dtype), v)

    o = sweep_query_blocks(block, q)
    o = rms_norm(o, g_sub) * (1.0 - lam_init)
    return o.reshape(B, S, GROUP_WIDTH)


def gqa_axial(q, k, v, g_q, g_k, row_cs, col_cs):
    B, S, _ = q.shape
    half = HEAD_DIM // 2
    def axial(z):
        return jnp.concatenate([apply_rope(z[..., :half], *row_cs),
                                apply_rope(z[..., half:], *col_cs)], axis=-1)
    q = axial(rms_norm(q.reshape(B, S, GQA_Q_HEADS, HEAD_DIM), g_q))
    k = axial(rms_norm(k.reshape(B, S, GQA_KV_HEADS, HEAD_DIM), g_k))
    v = v.reshape(B, S, GQA_KV_HEADS, HEAD_DIM)
    q = q.reshape(B, S, GQA_KV_HEADS, GQA_GROUP, HEAD_DIM)
    scale = HEAD_DIM ** -0.5

    def block(qb):
        s = jnp.einsum('bqkgd,bskd->bkgqs', qb, k).astype(jnp.float32) * scale
        p = jax.nn.softmax(s, axis=-1)
        return jnp.einsum('bkgqs,bskd->bqkgd', p.astype(v.dtype), v)

    o = sweep_query_blocks(block, q)
    return o.reshape(B, S, GROUP_WIDTH)


def cross_attention(xn, memn, w_q, w_kv, w_o, g_q, g_k):
    B, S, _ = xn.shape
    M = memn.shape[1]
    q = rms_norm((xn @ w_q).reshape(B, S, CROSS_HEADS, CROSS_HEAD_DIM), g_q)
    kv = (memn @ w_kv).reshape(B, M, 2, CROSS_HEADS, CROSS_HEAD_DIM)
    k = rms_norm(kv[:, :, 0], g_k)
    v = kv[:, :, 1]
    s = jnp.einsum('bshd,bmhd->bhsm', q, k).astype(jnp.float32) * (CROSS_HEAD_DIM ** -0.5)
    p = jax.nn.softmax(s, axis=-1)
    o = jnp.einsum('bhsm,bmhd->bshd', p.astype(v.dtype), v).reshape(B, S, D_MODEL)
    return o @ w_o


def conv_ffn(xn, w_in, conv_w, conv_b, w_out):
    h = xn @ w_in
    gate, up = h[..., :D_FF], h[..., D_FF:]
    gp = jnp.pad(gate, ((0, 0), (1, 1), (0, 0)))
    gconv = gp[:, :-2] * conv_w[0] + gp[:, 1:-1] * conv_w[1] + gp[:, 2:] * conv_w[2] + conv_b
    return (jax.nn.silu(gconv) * up) @ w_out


def setup_inputs(seed: int = 0) -> dict:
    key = jax.random.key(seed)
    keys = iter(jax.random.split(key, 40))
    f32 = jnp.float32
    def nrm(shape, scale):
        return scale * jax.random.normal(next(keys), shape, f32)
    def gain(shape):
        return 1.0 + 0.1 * jax.random.normal(next(keys), shape, f32)
    D = D_MODEL
    return {
        'x': jax.random.normal(next(keys), (BATCH, SEQ, D), f32),
        'mem': jax.random.normal(next(keys), (BATCH, MEM_LEN, D), f32),
        'norm_mix': gain((DEPTH, D)),
        'w_in': nrm((DEPTH, D, D_IN), D ** -0.5),
        'ml_bias_i': nrm((DEPTH, 2, ML_HEADS), 0.1),
        'ml_bias_f': 3.0 + 3.0 * jax.random.uniform(next(keys), (DEPTH, 2, ML_HEADS), f32),
        'ml_norm': gain((DEPTH, GROUP_WIDTH)),
        'pool_w': nrm((DEPTH, POOL_GROUPS, POOL_CH, POOL_CH), POOL_CH ** -0.5),
        'pool_scale': gain((DEPTH, GROUP_WIDTH)),
        'diff_qnorm': gain((DEPTH, DIFF_QK_DIM)),
        'diff_knorm': gain((DEPTH, DIFF_QK_DIM)),
        'diff_lambda': nrm((DEPTH, 4, DIFF_QK_DIM), 0.1),
        'diff_subnorm': gain((DEPTH, HEAD_DIM)),
        'gqa_qnorm': gain((DEPTH, HEAD_DIM)),
        'gqa_knorm': gain((DEPTH, HEAD_DIM)),
        'w_out': nrm((DEPTH, MIX_WIDTH, D), MIX_WIDTH ** -0.5),
        'norm_cross': gain((DEPTH, D)),
        'norm_mem': gain((DEPTH, D)),
        'w_cq': nrm((DEPTH, D, D), D ** -0.5),
        'w_ckv': nrm((DEPTH, D, 2 * D), D ** -0.5),
        'cross_qnorm': gain((DEPTH, CROSS_HEAD_DIM)),
        'cross_knorm': gain((DEPTH, CROSS_HEAD_DIM)),
        'w_co': nrm((DEPTH, D, D), D ** -0.5),
        'norm_ffn': gain((DEPTH, D)),
        'w_ffn_in': nrm((DEPTH, D, 2 * D_FF), D ** -0.5),
        'ffn_conv': nrm((DEPTH, CONV_W, D_FF), CONV_W ** -0.5),
        'ffn_conv_b': nrm((DEPTH, D_FF), 0.02),
        'w_ffn_out': nrm((DEPTH, D_FF, D), D_FF ** -0.5),
    }


def reference(x, mem, norm_mix, w_in, ml_bias_i, ml_bias_f, ml_norm, pool_w, pool_scale,
              diff_qnorm, diff_knorm, diff_lambda, diff_subnorm, gqa_qnorm, gqa_knorm, w_out,
              norm_cross, norm_mem, w_cq, w_ckv, cross_qnorm, cross_knorm, w_co,
              norm_ffn, w_ffn_in, ffn_conv, ffn_conv_b, w_ffn_out):
    B, S, _ = x.shape
    rows = S // GRID_W
    pos = jnp.arange(S)
    row = jnp.repeat(jnp.arange(rows), GRID_W)
    col = pos - row * GRID_W
    cos1, sin1 = rope_cos_sin(pos, DIFF_QK_DIM)
    row_cs = rope_cos_sin(row, HEAD_DIM // 2)
    col_cs = rope_cos_sin(col, HEAD_DIM // 2)
    splits, acc = [], 0
    for sz in IN_SIZES[:-1]:
        acc += sz
        splits.append(acc)

    for l in range(DEPTH):
        lam_init = 0.8 - 0.6 * math.exp(-0.3 * l)
        h = rms_norm(x, norm_mix[l])
        (ml_q, ml_k, ml_v, ml_o, ml_g, pool_u,
         d_q, d_k, d_v, g_q, g_k, g_v) = jnp.split(h @ w_in[l], splits, axis=-1)
        y_a = mlstm_mixer(ml_q, ml_k, ml_v, ml_o, ml_g, ml_bias_i[l], ml_bias_f[l], ml_norm[l])
        y_b = pool_mixer(pool_u, pool_w[l], pool_scale[l])
        y_c = diff_attention(d_q, d_k, d_v, diff_qnorm[l], diff_knorm[l], diff_lambda[l],
                             diff_subnorm[l], cos1, sin1, lam_init)
        y_d = gqa_axial(g_q, g_k, g_v, gqa_qnorm[l], gqa_knorm[l], row_cs, col_cs)
        x = x + jnp.concatenate([y_a, y_b, y_c, y_d], axis=-1) @ w_out[l]
        x = x + cross_attention(rms_norm(x, norm_cross[l]), rms_norm(mem, norm_mem[l]),
                                w_cq[l], w_ckv[l], w_co[l], cross_qnorm[l], cross_knorm[l])
        x = x + conv_ffn(rms_norm(x, norm_ffn[l]), w_ffn_in[l], ffn_conv[l], ffn_conv_b[l],
                         w_ffn_out[l])
    return x
```

```cpp
#include <hip/hip_runtime.h>
#include <hip/hip_cooperative_groups.h>
#include <hip/hip_bf16.h>
#include <cstdio>
#include <cstdint>
#include <cmath>
namespace cg = cooperative_groups;
__device__ __forceinline__ float bperm(int srclane, float v) { return __int_as_float(__builtin_amdgcn_ds_bpermute(srclane << 2, __float_as_int(v))); }
#define SHX(v, m) bperm(lane ^ (m), (v))
#define SHU(v, o) bperm(lane - (o), (v))
#define SHD(v, o) bperm(lane + (o), (v))
#define SHI(v, src) bperm((src), (v))

namespace pg8 {
#define PG8_LAS __attribute__((address_space(3)))
typedef unsigned short bf16_t;
typedef short bf16x8 __attribute__((ext_vector_type(8)));
typedef float f32x4 __attribute__((ext_vector_type(4)));
typedef unsigned u32x4 __attribute__((ext_vector_type(4)));
typedef unsigned u32x2 __attribute__((ext_vector_type(2)));
constexpr int BM = 256, BK = 64, HALF = 128, HTB = HALF * BK * 2  , STAGE_BYTES = 8 * HTB, NXCD = 8, WGM = 8;

__host__ __device__ __forceinline__ int lds_byte(int r, int c) { const int st = (r >> 4) * 2 + (c >> 5), rr = r & 15, cc = c & 31, ob = rr * 64 + cc * 2; return st * 1024 + (ob ^ (((ob >> 9) & 1) << 5)); }
__host__ __device__ __forceinline__ void stage_rc(int b, int& R, int& C) { const int st = b / 1024, sb = b % 1024, swz = sb ^ (((sb >> 9) & 1) << 5); R = (st >> 1) * 16 + swz / 64; C = (st & 1) * 32 + (swz % 64) / 2; }
__host__ __device__ __forceinline__ int perm32(int rho) { const int n = rho >> 4, i = rho & 15; return 8 * (i >> 2) + 4 * n + (i & 3); }

struct Unit { int pm, pn; };
template <int LDA, int LDB, int KK, long AT, long AN, long BN, long BZ, int ZDIV> struct GemmT {
    const bf16_t* A; const bf16_t* Bt;
    static constexpr int lda = LDA, ldb = LDB, K = KK;
    __device__ __forceinline__ long offA(const Unit& u) const { return (long)u.pm * AT + (long)u.pn * AN; }
    __device__ __forceinline__ long offB(const Unit& u) const { return (long)u.pn * BN + (ZDIV > 0 ? (long)(u.pm / (ZDIV > 0 ? ZDIV : 1)) * BZ : 0L); }
};
typedef GemmT<1024, 1024, 1024, 256L * 1024 * 2, 0, 256L * 1024 * 2, 0, 0> GemmK1024;
typedef GemmT<2816, 2816, 2816, 256L * 2816 * 2, 0, 256L * 2816 * 2, 0, 0> GemmK2816;
typedef GemmT<1024, 1024, 1024, 248L * 1024 * 2, 0, 256L * 1024 * 2, 0, 0> GemmConv;
typedef GemmT<1024, 256, 256, 256L * 1024 * 2, 512, 65536L * 2, 4L * 65536 * 2, 32> GemmHeads;

struct StaticOrder {
    int nM, nN, nwg, G, c;
    __host__ __device__ void init(int nM_, int nN_, int G_, int c_) { nM = nM_; nN = nN_; nwg = nM * nN; G = G_; c = c_; }
    __host__ __device__ bool next(int i, Unit& u) const {
        const long L = (long)i * G + c; if (L >= nwg) return false;
        int wgid = (int)L; { const int q = nwg / NXCD, r = nwg % NXCD, xcd = wgid % NXCD, off = wgid / NXCD; wgid = (xcd < r ? xcd * (q + 1) : r * (q + 1) + (xcd - r) * q) + off; }
        const int nig = WGM * nN, gid = wgid / nig, fm = gid * WGM, gsz = (nM - fm) < WGM ? (nM - fm) : WGM;
        u.pm = fm + ((wgid % nig) % gsz); u.pn = (wgid % nig) / gsz; return true;
    }
    __device__ __forceinline__ void a_ready(const Unit&) const {}
    __device__ __forceinline__ void done(const Unit&) const {}
};
__device__ __forceinline__ unsigned cvt_pk_bf16(float lo, float hi) { unsigned r; asm volatile("v_cvt_pk_bf16_f32 %0, %1, %2" : "=v"(r) : "v"(lo), "v"(hi)); return r; }


template <class GT, class Epi, class Sched, bool ALIGN_EPI = false, bool SP2 = false, bool CONV = false>
__device__ __forceinline__ void gemm_phase(PG8_LAS unsigned char* lds, const GT g, const Sched& S, const Epi& E, const int tid_in) {
    static_assert(SP2, "only the SP2 loop is kept valid here");
    int tid_l = tid_in; asm volatile("" : "+v"(tid_l));
    const int tid = tid_l, wid = __builtin_amdgcn_readfirstlane(tid >> 6), lane = tid & 63, wr = wid >> 2, wc = wid & 3, fr = lane & 15, fq = lane >> 4;
    constexpr int nt = GT::K / BK;
    unsigned voffA[2], voffB[2];
#pragma unroll
    for (int i = 0; i < 2; ++i) { int R, C; stage_rc(tid * 16 + i * 8192, R, C); const int Rb = Epi::PERM ? ((R & ~31) + perm32(R & 31)) : R;
        const int Ra = CONV ? (R - 2 * (R >> 6)) : R; voffA[i] = (unsigned)(Ra * GT::lda + C) * 2u; voffB[i] = (unsigned)(Rb * GT::ldb + C) * 2u; }
    const size_t kstep = (size_t)(BK * 2);
    constexpr size_t hA = (size_t)(CONV ? 124 : HALF) * GT::lda * 2, hB = (size_t)HALF * GT::ldb * 2;
    const unsigned ldsw = (unsigned)wid * 1024u;
    const int aoff = lds_byte(wr * 64 + fr, fq * 8), boff = lds_byte(wc * 32 + fr, fq * 8);
#define PG8_SA(b, h) (((b) * 2 + (h)) * HTB)
#define PG8_SB(b, h) ((4 + (b) * 2 + (h)) * HTB)
#define PG8_STAGE(bufoff, gbase, voff) do { _Pragma("unroll") for (int _i = 0; _i < 2; ++_i) \
        __builtin_amdgcn_global_load_lds((const unsigned*)((const char*)(gbase) + (voff)[_i]), (PG8_LAS unsigned*)(lds + (bufoff) + ldsw + _i * 8192), 16, 0, 0); } while (0)
#define PG8_LDA(dst, b, h) do { _Pragma("unroll") for (int m = 0; m < 4; ++m) _Pragma("unroll") for (int k = 0; k < 2; ++k) dst[m][k] = *(const PG8_LAS bf16x8*)(lds + PG8_SA(b, h) + aoff + m * 2048 + k * 1024); } while (0)
#define PG8_LDB(dst, b, h) do { _Pragma("unroll") for (int n = 0; n < 2; ++n) _Pragma("unroll") for (int k = 0; k < 2; ++k) dst[n][k] = *(const PG8_LAS bf16x8*)(lds + PG8_SB(b, h) + boff + n * 2048 + k * 1024); } while (0)
#define PG8_MMA(ai, bj, At, Bt) do { __builtin_amdgcn_s_setprio(1); _Pragma("unroll") for (int m = 0; m < 4; ++m) _Pragma("unroll") for (int n = 0; n < 2; ++n) _Pragma("unroll") for (int k = 0; k < 2; ++k) \
        acc[ai][bj][m][n] = __builtin_amdgcn_mfma_f32_16x16x32_bf16(Bt[n][k], At[m][k], acc[ai][bj][m][n], 0, 0, 0); __builtin_amdgcn_s_setprio(0); } while (0)
#define PG8_WAIT_V(n) asm volatile("s_waitcnt vmcnt(" #n ")" ::: "memory")
#define PG8_WAIT_L(n) asm volatile("s_waitcnt lgkmcnt(" #n ")" ::: "memory")
#define PG8_BAR __builtin_amdgcn_s_barrier()
#define PG8_SCHED __builtin_amdgcn_sched_barrier(0)
    Unit cur, nxt; int ui = 0;
    if (!S.next(0, cur)) return;
    f32x4 acc[2][2][4][2];
#pragma unroll
    for (int a = 0; a < 2; ++a)
#pragma unroll
        for (int b = 0; b < 2; ++b)
#pragma unroll
            for (int m = 0; m < 4; ++m)
#pragma unroll
                for (int n = 0; n < 2; ++n) acc[a][b][m][n] = (f32x4){0.f, 0.f, 0.f, 0.f};
    bf16x8 At[4][2], B0[2][2], B1[2][2];
    const char* cA = (const char*)g.A + g.offA(cur); const char* cB = (const char*)g.Bt + g.offB(cur);
    S.a_ready(cur);
    if constexpr (SP2) {
        PG8_STAGE(PG8_SB(0, 0), cB, voffB); PG8_STAGE(PG8_SB(0, 1), cB + hB, voffB); PG8_STAGE(PG8_SA(0, 0), cA, voffA); PG8_STAGE(PG8_SA(0, 1), cA + hA, voffA);
        if (wr == 1) PG8_BAR;
        PG8_WAIT_V(2); PG8_BAR;
        PG8_STAGE(PG8_SB(1, 0), cB + kstep, voffB); PG8_STAGE(PG8_SA(1, 0), cA + kstep, voffA); PG8_STAGE(PG8_SB(1, 1), cB + hB + kstep, voffB);
        PG8_WAIT_V(6); PG8_BAR;
    } else {
        PG8_STAGE(PG8_SB(0, 0), cB, voffB); PG8_STAGE(PG8_SA(0, 0), cA, voffA); PG8_STAGE(PG8_SB(0, 1), cB + hB, voffB); PG8_STAGE(PG8_SA(0, 1), cA + hA, voffA);
        if (wr == 1) PG8_BAR;
        PG8_WAIT_V(4); PG8_BAR;
        PG8_STAGE(PG8_SB(1, 0), cB + kstep, voffB); PG8_STAGE(PG8_SA(1, 0), cA + kstep, voffA); PG8_STAGE(PG8_SB(1, 1), cB + hB + kstep, voffB);
        PG8_WAIT_V(6); PG8_BAR;
    }
    for (;;) {
        const bool has_next = S.next(ui + 1, nxt);
        const char* nA = has_next ? (const char*)g.A + g.offA(nxt) : cA; const char* nB = has_next ? (const char*)g.Bt + g.offB(nxt) : cB;
        for (int t = 0; t < nt; t += 2) {
            const bool last = (t == nt - 2);
            const char* a1 = cA + (size_t)(t + 1) * kstep;
            const char* a2 = last ? nA : cA + (size_t)(t + 2) * kstep; const char* b2 = last ? nB : cB + (size_t)(t + 2) * kstep;
            const char* a3 = a2 + kstep; const char* b3 = b2 + kstep;
            if (last && has_next) S.a_ready(nxt);
            if constexpr (SP2) {
            PG8_LDB(B0, 0, 0); PG8_LDB(B1, 0, 1); PG8_SCHED; PG8_LDA(At, 0, 0); PG8_STAGE(PG8_SA(1, 1), a1 + hA, voffA);
            PG8_WAIT_V(8); PG8_WAIT_L(0); PG8_BAR; PG8_MMA(0, 0, At, B0); PG8_MMA(0, 1, At, B1); PG8_BAR; PG8_SCHED;
            PG8_LDA(At, 0, 1); PG8_STAGE(PG8_SB(0, 0), b2, voffB); PG8_STAGE(PG8_SB(0, 1), b2 + hB, voffB); PG8_STAGE(PG8_SA(0, 0), a2, voffA);
            PG8_WAIT_V(8); PG8_WAIT_L(0); PG8_BAR; PG8_MMA(1, 0, At, B0); PG8_MMA(1, 1, At, B1); PG8_BAR; PG8_SCHED;
            PG8_LDB(B0, 1, 0); PG8_LDB(B1, 1, 1); PG8_SCHED; PG8_LDA(At, 1, 0); PG8_STAGE(PG8_SA(0, 1), a2 + hA, voffA);
            PG8_WAIT_V(8); PG8_WAIT_L(0); PG8_BAR; PG8_MMA(0, 0, At, B0); PG8_MMA(0, 1, At, B1); PG8_BAR; PG8_SCHED;
            PG8_LDA(At, 1, 1); PG8_STAGE(PG8_SB(1, 0), b3, voffB); PG8_STAGE(PG8_SB(1, 1), b3 + hB, voffB); PG8_STAGE(PG8_SA(1, 0), a3, voffA);
            PG8_WAIT_V(8); PG8_WAIT_L(0); PG8_BAR; PG8_MMA(1, 0, At, B0); PG8_MMA(1, 1, At, B1); PG8_BAR; PG8_SCHED;
            } else {
            PG8_LDB(B0, 0, 0); PG8_SCHED; PG8_LDA(At, 0, 0); PG8_STAGE(PG8_SA(1, 1), a1 + hA, voffA);
            PG8_WAIT_L(8); PG8_BAR; PG8_WAIT_L(0); PG8_MMA(0, 0, At, B0); PG8_BAR; PG8_SCHED;
            PG8_LDB(B1, 0, 1); PG8_STAGE(PG8_SB(0, 0), b2, voffB);
            PG8_BAR; PG8_WAIT_L(0); PG8_MMA(0, 1, At, B1); PG8_BAR;
            PG8_LDA(At, 0, 1); PG8_STAGE(PG8_SA(0, 0), a2, voffA);
            PG8_BAR; PG8_WAIT_L(0); PG8_MMA(1, 0, At, B0); PG8_BAR; PG8_SCHED;
            PG8_STAGE(PG8_SB(0, 1), b2 + hB, voffB);
            PG8_WAIT_V(6); PG8_BAR; PG8_MMA(1, 1, At, B1); PG8_BAR;
            PG8_LDB(B0, 1, 0); PG8_SCHED; PG8_LDA(At, 1, 0); PG8_STAGE(PG8_SA(0, 1), a2 + hA, voffA);
            PG8_WAIT_L(8); PG8_BAR; PG8_WAIT_L(0); PG8_MMA(0, 0, At, B0); PG8_BAR; PG8_SCHED;
            PG8_LDB(B1, 1, 1); PG8_STAGE(PG8_SB(1, 0), b3, voffB);
            PG8_BAR; PG8_WAIT_L(0); PG8_MMA(0, 1, At, B1); PG8_BAR;
            PG8_LDA(At, 1, 1); PG8_STAGE(PG8_SA(1, 0), a3, voffA);
            PG8_BAR; PG8_WAIT_L(0); PG8_MMA(1, 0, At, B0); PG8_BAR; PG8_SCHED;
            PG8_STAGE(PG8_SB(1, 1), b3 + hB, voffB);
            PG8_WAIT_V(6); PG8_BAR; PG8_MMA(1, 1, At, B1); PG8_BAR;
            }
        }
        if constexpr (ALIGN_EPI) { if (wr == 0) PG8_BAR; }
        if constexpr (!Epi::AFTER_DRAIN) { { int l_e; asm volatile("v_mbcnt_lo_u32_b32 %0, -1, 0\n\tv_mbcnt_hi_u32_b32 %0, -1, %0" : "=v"(l_e)); E(acc, cur, wr, wc, l_e & 15, l_e >> 4); } S.done(cur); }
        if (!has_next) break;
#pragma unroll
        for (int a = 0; a < 2; ++a)
#pragma unroll
            for (int b = 0; b < 2; ++b)
#pragma unroll
                for (int m = 0; m < 4; ++m)
#pragma unroll
                    for (int n = 0; n < 2; ++n) acc[a][b][m][n] = (f32x4){0.f, 0.f, 0.f, 0.f};
        cur = nxt; cA = nA; cB = nB; ++ui;
        if constexpr (ALIGN_EPI) { if (wr == 1) PG8_BAR; }
    }
    PG8_WAIT_V(0);
    if constexpr (!ALIGN_EPI) { if (wr == 0) PG8_BAR; }
    PG8_BAR;
    if constexpr (Epi::AFTER_DRAIN) { E.fused(acc, cur, wr, wc, fr, fq, lds, wid, lane); S.done(cur); }
#undef PG8_SA
#undef PG8_SB
#undef PG8_STAGE
#undef PG8_LDA
#undef PG8_LDB
#undef PG8_MMA
#undef PG8_WAIT_V
#undef PG8_WAIT_L
#undef PG8_BAR
#undef PG8_SCHED
}

typedef f32x4 Acc[2][2][4][2];
__device__ __forceinline__ float sum16(const float* p) {
    const f32x4 a = *(const f32x4*)p, b = *(const f32x4*)(p + 4), c = *(const f32x4*)(p + 8), d = *(const f32x4*)(p + 12);
    return ((a[0] + a[1]) + (a[2] + a[3])) + ((b[0] + b[1]) + (b[2] + b[3])) + ((c[0] + c[1]) + (c[2] + c[3])) + ((d[0] + d[1]) + (d[2] + d[3]));
}
__device__ __forceinline__ float dot4(const f32x4 v) { return (v[0] * v[0] + v[1] * v[1]) + (v[2] * v[2] + v[3] * v[3]); }
__device__ __forceinline__ u32x4 pack8(const f32x4 a, const f32x4 b) { u32x4 w; w.x = cvt_pk_bf16(a[0], a[1]); w.y = cvt_pk_bf16(a[2], a[3]); w.z = cvt_pk_bf16(b[0], b[1]); w.w = cvt_pk_bf16(b[2], b[3]); return w; }

struct EpiScaled {
    static constexpr bool PERM = true, AFTER_DRAIN = false;
    bf16_t* O; int ldc; const float* ssq; float* HS;
    __device__ __forceinline__ void operator()(Acc& acc, const Unit& u, int wr, int wc, int fr, int fq) const {
        const int lane = fq * 16 + fr; (void)lane; const int row0 = u.pm * BM + wr * 64 + fr, col0 = u.pn * BM + wc * 32 + 8 * fq;
#pragma unroll
        for (int ai = 0; ai < 2; ++ai)
#pragma unroll
            for (int m = 0; m < 4; ++m) { if ((m & 1) == 0) asm volatile("" ::: "memory"); const int r = row0 + ai * HALF + m * 16; const float rs = __builtin_amdgcn_rsqf(sum16(ssq + (size_t)r * 16) * (1.0f / 1024.0f) + 1e-6f);
                bf16_t* rowp = O + (size_t)r * ldc + col0; float ss = 0.f;
#pragma unroll
                for (int bj = 0; bj < 2; ++bj) { const f32x4 v0 = acc[ai][bj][m][0] * rs, v1 = acc[ai][bj][m][1] * rs; ss += dot4(v0) + dot4(v1); *(u32x4*)(rowp + bj * HALF) = pack8(v0, v1); }
                if (HS) { ss += SHX(ss, 16); ss += SHX(ss, 32); if (fq == 0) HS[(size_t)r * 16 + u.pn * 4 + wc] = ss; } }
    }
};
struct EpiRes {
    static constexpr bool PERM = false, AFTER_DRAIN = false;
    const float* base; float* out; bf16_t* xb; float* ssq;
    __device__ __forceinline__ void operator()(Acc& acc, const Unit& u, int wr, int wc, int fr, int fq) const {
        const int lane = fq * 16 + fr; (void)lane; const int row0 = u.pm * BM + wr * 64 + fr, col0 = u.pn * BM + wc * 32 + 4 * fq;
#pragma unroll
        for (int ai = 0; ai < 2; ++ai)
#pragma unroll
            for (int m = 0; m < 4; ++m) { if ((m & 1) == 0) asm volatile("" ::: "memory"); const int r = row0 + ai * HALF + m * 16; const size_t off = (size_t)r * 1024 + col0; float ss = 0.f;
#pragma unroll
                for (int bj = 0; bj < 2; ++bj)
#pragma unroll
                    for (int n = 0; n < 2; ++n) { const f32x4 o = *(const f32x4*)(base + off + bj * HALF + n * 16) + acc[ai][bj][m][n]; *(f32x4*)(out + off + bj * HALF + n * 16) = o; ss += dot4(o);
                        u32x2 w; w.x = cvt_pk_bf16(o[0], o[1]); w.y = cvt_pk_bf16(o[2], o[3]); *(u32x2*)(xb + off + bj * HALF + n * 16) = w; }
                ss += SHX(ss, 16); ss += SHX(ss, 32); if (fq == 0) ssq[(size_t)r * 16 + u.pn * 4 + wc] = ss; }
    }
};
struct EpiF32 {
    static constexpr bool PERM = false, AFTER_DRAIN = false;
    float* out; int ldc;
    __device__ __forceinline__ void operator()(Acc& acc, const Unit& u, int wr, int wc, int fr, int fq) const {
        const int lane = fq * 16 + fr; (void)lane; const int row0 = u.pm * BM + wr * 64 + fr, col0 = u.pn * BM + wc * 32 + 4 * fq;
#pragma unroll
        for (int ai = 0; ai < 2; ++ai)
#pragma unroll
            for (int m = 0; m < 4; ++m) { const size_t off = (size_t)(row0 + ai * HALF + m * 16) * ldc + col0;
#pragma unroll
                for (int bj = 0; bj < 2; ++bj)
#pragma unroll
                    for (int n = 0; n < 2; ++n) *(f32x4*)(out + off + bj * HALF + n * 16) = acc[ai][bj][m][n]; }
    }
};
struct EpiScore {
    static constexpr bool PERM = true, AFTER_DRAIN = false;
    bf16_t* PT; const float* HS; float* PS;
    __device__ __forceinline__ void operator()(Acc& acc, const Unit& u, int wr, int wc, int fr, int fq) const {
        const int lane = fq * 16 + fr; (void)lane; const int row0 = u.pm * BM + wr * 64 + fr, col0 = u.pn * BM + wc * 32 + 8 * fq;
#pragma unroll
        for (int ai = 0; ai < 2; ++ai)
#pragma unroll
            for (int m = 0; m < 4; ++m) { const int r = row0 + ai * HALF + m * 16; const f32x4 h4 = *(const f32x4*)(HS + (size_t)r * 16 + u.pn * 4);
                const float rq = __builtin_amdgcn_rsqf(((h4[0] + h4[1]) + (h4[2] + h4[3])) * (1.0f / 256.0f) + 1e-6f); bf16_t* rowp = PT + (size_t)r * 1024 + col0; float ss = 0.f;
#pragma unroll
                for (int bj = 0; bj < 2; ++bj) { f32x4 v0 = acc[ai][bj][m][0] * rq, v1 = acc[ai][bj][m][1] * rq;
#pragma unroll
                    for (int j = 0; j < 4; ++j) { v0[j] = __builtin_amdgcn_exp2f(v0[j]); v1[j] = __builtin_amdgcn_exp2f(v1[j]); }
                    ss += ((v0[0] + v0[1]) + (v0[2] + v0[3])) + ((v1[0] + v1[1]) + (v1[2] + v1[3])); *(u32x4*)(rowp + bj * HALF) = pack8(v0, v1); }
                ss += SHX(ss, 16); ss += SHX(ss, 32); if (fq == 0) PS[(size_t)r * 16 + u.pn * 4 + wc] = ss; }
    }
};
struct EpiPV {
    static constexpr bool PERM = true, AFTER_DRAIN = false;
    bf16_t* O; const float* PS;
    __device__ __forceinline__ void operator()(Acc& acc, const Unit& u, int wr, int wc, int fr, int fq) const {
        const int lane = fq * 16 + fr; (void)lane; const int row0 = u.pm * BM + wr * 64 + fr, col0 = u.pn * BM + wc * 32 + 8 * fq;
#pragma unroll
        for (int ai = 0; ai < 2; ++ai)
#pragma unroll
            for (int m = 0; m < 4; ++m) { const int r = row0 + ai * HALF + m * 16; const f32x4 p4 = *(const f32x4*)(PS + (size_t)r * 16 + u.pn * 4);
                const float inv = 1.0f / ((p4[0] + p4[1]) + (p4[2] + p4[3])); bf16_t* rowp = O + (size_t)r * 1024 + col0;
#pragma unroll
                for (int bj = 0; bj < 2; ++bj) *(u32x4*)(rowp + bj * HALF) = pack8(acc[ai][bj][m][0] * inv, acc[ai][bj][m][1] * inv); }
    }
};
struct EpiFFN {
    static constexpr bool PERM = true, AFTER_DRAIN = false;
    bf16_t* act; const float* ssq; const float* cw; const float* cb; int Mrows;
    __device__ __forceinline__ void operator()(Acc& acc, const Unit& u, int wr, int wc, int fr, int fq) const {
        const int lane = fq * 16 + fr; const int jc = u.pn * 128 + wc * 32 + 8 * fq;
#pragma unroll
        for (int ai = 0; ai < 2; ++ai) {
            const int g0 = 62 * (4 * u.pm + 2 * ai + wr) - 1;
            float rsv[4];
#pragma unroll
            for (int m = 0; m < 4; ++m) { const int gr = g0 + 16 * m + fr; const bool valid = gr >= 0 && gr < Mrows; const int grc = valid ? gr : 0;
                const float rs = __builtin_amdgcn_rsqf(sum16(ssq + (size_t)grc * 16) * (1.0f / 1024.0f) + 1e-6f); rsv[m] = valid ? rs : 0.f;
                asm volatile("" : "+v"(rsv[m]) :: "memory"); __builtin_amdgcn_sched_barrier(0); }
#pragma unroll
            for (int m = 0; m < 4; ++m)
#pragma unroll
                for (int bj = 0; bj < 2; ++bj)
#pragma unroll
                    for (int n = 0; n < 2; ++n)
#pragma unroll
                        for (int j = 0; j < 4; ++j) { const float v = acc[ai][bj][m][n][j] * rsv[m]; acc[ai][bj][m][n][j] = (rsv[m] == 0.f) ? 0.f : v; }
#pragma unroll
            for (int m = 0; m < 4; ++m) { const int rr = 16 * m + fr, gr = g0 + rr, t = gr & 8191; f32x4 o[2];
#pragma unroll
                for (int n = 0; n < 2; ++n) {
                    asm volatile("" ::: "memory");
                    const f32x4 w0 = *(const f32x4*)(cw + jc + 4 * n), w1 = *(const f32x4*)(cw + 2816 + jc + 4 * n), w2 = *(const f32x4*)(cw + 5632 + jc + 4 * n), bb = *(const f32x4*)(cb + jc + 4 * n);
#pragma unroll
                    for (int j = 0; j < 4; ++j) { const float cur = acc[ai][0][m][n][j];
                        const float up_same = SHI(cur, lane - 1), dn_same = SHI(cur, lane + 1);
                        const float up_wrap = (m > 0) ? SHI(acc[ai][0][m > 0 ? m - 1 : 0][n][j], lane + 15) : 0.f;
                        const float dn_wrap = (m < 3) ? SHI(acc[ai][0][m < 3 ? m + 1 : 3][n][j], lane - 15) : 0.f;
                        float prev = (fr == 0) ? up_wrap : up_same, next = (fr == 15) ? dn_wrap : dn_same;
                        prev = (t == 0) ? 0.f : prev; next = (t == 8191) ? 0.f : next;
                        const float gc = w0[j] * prev + w1[j] * cur + w2[j] * next + bb[j];
                        o[n][j] = gc / (1.0f + __expf(-gc)) * acc[ai][1][m][n][j]; }
                    __builtin_amdgcn_sched_barrier(0); }
                if (rr >= 1 && rr <= 62 && gr < Mrows) *(u32x4*)(act + (size_t)gr * 2816 + jc) = pack8(o[0], o[1]); }
        }
    }
};
}

namespace attn_body {
using bf16=__hip_bfloat16;
using bf16x8=__attribute__((ext_vector_type(8)))short;
using s16x4=__attribute__((ext_vector_type(4)))short;
using f32x16=__attribute__((ext_vector_type(16)))float;
using u32x4=__attribute__((ext_vector_type(4)))unsigned;
constexpr int SEQ=8192,D=64,ldk=2560,ldv=2560;
constexpr int NW=8,QBLK=32,QB=QBLK*NW,KVBLK=64,NQB=SEQ/QB;
constexpr int ATTN_UNIT_ROWS=QB;
__device__ __forceinline__ int crow(int r,int hi){return (r&3)+8*(r>>2)+4*hi;}
#define SBAR() __builtin_amdgcn_sched_barrier(0)
__device__ __forceinline__ void cmask(f32x16&p0,f32x16&p1,int jb,int qrel,int hi){
  const float NEG=-INFINITY; int kb=64*jb+4*hi;
  #pragma unroll
  for(int r=0;r<16;++r){int kv=kb+(r&3)+8*(r>>2); if(kv>qrel)p0[r]=NEG; if(kv+32>qrel)p1[r]=NEG;}
}

constexpr int NSLOT=3, SLOTB=8192;
constexpr int LDS_K=0, LDS_V=NSLOT*SLOTB, LDS_WS=2*NSLOT*SLOTB, LDS_OST=LDS_WS+NW*64*4, LDS_BYTES=LDS_OST+NW*4096;
constexpr float C2=0.125f*1.4426950408889634f;
__device__ __forceinline__ void glds16(const void*gsrc,unsigned lds_dst){unsigned keep;
  asm volatile("s_mov_b32 %0, m0\n\ts_mov_b32 m0, %2\n\ts_nop 0\n\tglobal_load_lds_dwordx4 %1, off\n\ts_mov_b32 m0, %0":"=&s"(keep):"v"(gsrc),"s"(lds_dst):"memory");}
__device__ __forceinline__ float max3f(float a,float b,float c){float r;asm("v_max3_f32 %0, %1, %2, %3":"=v"(r):"v"(a),"v"(b),"v"(c));return r;}
__device__ __forceinline__ float max2f(float a,float b){float r;asm("v_max_f32_e32 %0, %1, %2":"=v"(r):"v"(a),"v"(b));return r;}
__device__ __forceinline__ float fadd_s(float a,float b){float r;asm("v_add_f32_e32 %0, %1, %2":"=v"(r):"v"(a),"v"(b));return r;}
__device__ __forceinline__ float fsub_s(float a,float b){float r;asm("v_sub_f32_e32 %0, %1, %2":"=v"(r):"v"(a),"v"(b));return r;}
typedef float f32x2_t __attribute__((ext_vector_type(2))); typedef __bf16 bf16x2_t __attribute__((ext_vector_type(2)));
__device__ __forceinline__ unsigned cvtpk_s(float lo,float hi){f32x2_t v={lo,hi};bf16x2_t b=__builtin_convertvector(v,bf16x2_t);return __builtin_bit_cast(unsigned,b);}
#define WAIT_BAR(N) asm volatile("s_waitcnt vmcnt(" #N ") lgkmcnt(0)\n\ts_barrier":::"memory")

__device__ __forceinline__ void qkt(f32x16&p0,f32x16&p1,const char*Kslot,const bf16x8*qr,const f32x16&negm,int r32,int hi){
  const char*kb=Kslot+hi*1024+r32*16;
  #pragma unroll
  for(int d0=0;d0<4;++d0){
    const bf16x8 b0=*reinterpret_cast<const bf16x8*>(kb+d0*2048);
    const bf16x8 b1=*reinterpret_cast<const bf16x8*>(kb+d0*2048+512);
    if(d0==0){p0=__builtin_amdgcn_mfma_f32_32x32x16_bf16(b0,qr[0],negm,0,0,0);p1=__builtin_amdgcn_mfma_f32_32x32x16_bf16(b1,qr[0],negm,0,0,0);}
    else{p0=__builtin_amdgcn_mfma_f32_32x32x16_bf16(b0,qr[d0],p0,0,0,0);p1=__builtin_amdgcn_mfma_f32_32x32x16_bf16(b1,qr[d0],p1,0,0,0);}}
}
typedef __attribute__((address_space(3))) const char* lds_cptr;
typedef short v4i16_t __attribute__((ext_vector_type(4)));
__device__ __forceinline__ void kload8(bf16x8*kf,lds_cptr kp){
  kf[0]=*(const __attribute__((address_space(3))) bf16x8*)(kp);      kf[1]=*(const __attribute__((address_space(3))) bf16x8*)(kp+512);
  kf[2]=*(const __attribute__((address_space(3))) bf16x8*)(kp+2048); kf[3]=*(const __attribute__((address_space(3))) bf16x8*)(kp+2560);
  kf[4]=*(const __attribute__((address_space(3))) bf16x8*)(kp+4096); kf[5]=*(const __attribute__((address_space(3))) bf16x8*)(kp+4608);
  kf[6]=*(const __attribute__((address_space(3))) bf16x8*)(kp+6144); kf[7]=*(const __attribute__((address_space(3))) bf16x8*)(kp+6656);
}
__device__ __forceinline__ void kload2(bf16x8*kf,lds_cptr kp,int j){ kf[2*j]=*(const __attribute__((address_space(3))) bf16x8*)(kp+j*2048); kf[2*j+1]=*(const __attribute__((address_space(3))) bf16x8*)(kp+j*2048+512); }
__device__ __forceinline__ s16x4 vtr(lds_cptr p){ return __builtin_bit_cast(s16x4,__builtin_amdgcn_ds_read_tr16_b64_v4i16((__attribute__((address_space(3))) v4i16_t*)p)); }
__device__ __forceinline__ float rowmax(const f32x16&p0,const f32x16&p1){
  float a=max3f(p0[0],p0[1],p1[0]),b=max3f(p0[2],p0[3],p1[1]);a=max3f(a,p1[2],p1[3]);
  #pragma unroll
  for(int r=4;r<16;r+=4){a=max3f(a,p0[r],p0[r+1]);b=max3f(b,p0[r+2],p0[r+3]);a=max3f(a,p1[r],p1[r+1]);b=max3f(b,p1[r+2],p1[r+3]);}
  const float m=max2f(a,b);
  auto rr=__builtin_amdgcn_permlane32_swap(__float_as_uint(m),__float_as_uint(m),false,false);
  return max2f(__uint_as_float(rr[0]),__uint_as_float(rr[1]));
}
__device__ __forceinline__ void pv(f32x16*o,int vb,bf16x8 pa0,bf16x8 pa1,bf16x8 pa2,bf16x8 pa3){
  #pragma unroll
  for(int d0=0;d0<2;++d0){s16x4 lo[4],hi[4];
    #pragma unroll
    for(int ks=0;ks<4;++ks){
      asm volatile("ds_read_b64_tr_b16 %0,%1 offset:%c2":"=&v"(lo[ks]):"v"(vb),"i"(d0*4096+ks*1024):"memory");
      asm volatile("ds_read_b64_tr_b16 %0,%1 offset:%c2":"=&v"(hi[ks]):"v"(vb),"i"(d0*4096+ks*1024+512):"memory");}
    asm volatile("s_waitcnt lgkmcnt(0)":::"memory");SBAR();
    #define PK(k) (bf16x8){lo[k][0],lo[k][1],lo[k][2],lo[k][3],hi[k][0],hi[k][1],hi[k][2],hi[k][3]}
    o[d0]=__builtin_amdgcn_mfma_f32_32x32x16_bf16(pa0,PK(0),o[d0],0,0,0);
    o[d0]=__builtin_amdgcn_mfma_f32_32x32x16_bf16(pa1,PK(1),o[d0],0,0,0);
    o[d0]=__builtin_amdgcn_mfma_f32_32x32x16_bf16(pa2,PK(2),o[d0],0,0,0);
    o[d0]=__builtin_amdgcn_mfma_f32_32x32x16_bf16(pa3,PK(3),o[d0],0,0,0);
    #undef PK
  }
}

#ifndef ATTN_STORE16
#define ATTN_STORE16(p,v) (*(u32x4*)(p)=(v))
#endif
template<int THRL> __device__ __forceinline__ void attn_unit(const bf16*Qb,int ldq,const bf16*Kh,const bf16*Vh,bf16*Ob,int ldo,char*shm,const int tid_in){
  int tid_l=tid_in; asm volatile("":"+v"(tid_l));
  const int tid=tid_l,lane=tid&63,r32=lane&31,hi=lane>>5; const int wid=__builtin_amdgcn_readfirstlane(tid>>6);
  const bf16*Qw=Qb+(long)(wid*QBLK)*ldq;
  const unsigned lds0=(unsigned)(uintptr_t)shm;
  float*wsf=(float*)(shm+LDS_WS)+wid*64;
  const bf16*ksrc=Kh+(long)lane*ldk+wid*8;
  const bf16*vsrc=Vh+(long)(16*(wid&3)+(lane>>2))*ldv+(wid>>2)*32+(lane&3)*8;
  const unsigned kdst=lds0+LDS_K+wid*1024, vdst=lds0+LDS_V+wid*1024;
  #define DMA_K(t,slot) glds16(ksrc+(long)(t)*KVBLK*ldk,(unsigned)__builtin_amdgcn_readfirstlane(kdst+(slot)))
  #define DMA_V(t,slot) glds16(vsrc+(long)(t)*KVBLK*ldv,(unsigned)__builtin_amdgcn_readfirstlane(vdst+(slot)))
  const int vb0=(int)(lds0+LDS_V)+((lane>>4)&1)*32+(lane&3)*8+(4*hi+((lane&15)>>2))*64;
  const char*Kbase=shm+LDS_K; bf16x8 kf[8];
  const lds_cptr shm3=(lds_cptr)shm; const lds_cptr kp0=shm3+LDS_K+hi*1024+r32*16; const lds_cptr vp0=shm3+LDS_V+((lane>>4)&1)*32+(lane&3)*8+(4*hi+((lane&15)>>2))*64;
  constexpr int NT=SEQ/KVBLK;
  DMA_K(0,0);DMA_V(0,0);DMA_K(1,SLOTB);
  bf16x8 qr[4];
  #pragma unroll
  for(int d0=0;d0<4;++d0)qr[d0]=*reinterpret_cast<const bf16x8*>(&Qw[(long)r32*ldq+d0*16+hi*8]);
  float mhat=0.f,l_reg=0.f;f32x16 o[2];o[0]=f32x16{};o[1]=f32x16{};f32x16 negm=f32x16{};asm volatile("":"+v"(negm));
  #define CMASK(P0,P1,t) do{}while(0)
  bool resc=false;
  #define START(P0,P1) do{ const float rm=rowmax(P0,P1); resc=false; \
    { const float dl=rm; mhat=fadd_s(mhat,dl); \
      _Pragma("unroll") for(int r=0;r<16;++r){P0[r]=fsub_s(P0[r],dl);P1[r]=fsub_s(P1[r],dl);} \
      _Pragma("unroll") for(int r=0;r<16;++r)negm[r]=-mhat; asm volatile("":"+v"(negm)); } \
    _Pragma("unroll") for(int r=0;r<16;++r)P0[r]=__builtin_amdgcn_exp2f(P0[r]); }while(0)
  #define RESC() do{ if(resc){ asm volatile("s_waitcnt lgkmcnt(0)":::"memory"); \
      _Pragma("unroll") for(int d_=0;d_<2;++d_) _Pragma("unroll") for(int r=0;r<16;++r)o[d_][r]*=wsf[crow(r,hi)]; } }while(0)
  f32x16 pA0,pA1,pB0,pB1;
  int sl_prev=0,sl_cur=0,sl_next=SLOTB;
  #define ROT() do{sl_prev=sl_cur;sl_cur=sl_next;sl_next=(sl_next==(NSLOT-1)*SLOTB)?0:sl_next+SLOTB;}while(0)
  DMA_K(2,2*SLOTB);
  WAIT_BAR(3);
  qkt(pA0,pA1,Kbase,qr,negm,r32,hi);asm volatile("s_nop 15\n\ts_nop 7":"+v"(pA0),"+v"(pA1));CMASK(pA0,pA1,0);
  START(pA0,pA1);
  _Pragma("unroll") for(int r=0;r<16;++r)pA1[r]=__builtin_amdgcn_exp2f(pA1[r]);
  WAIT_BAR(0);
  DMA_K(3,0);DMA_V(1,SLOTB);
  ROT();
  kload8(kf,kp0+sl_cur);
  WAIT_BAR(2);
  s16x4 vlo[8],vhi[8]; u32x4 pw0,pw1,pw2,pw3;
  #define PKW(P,B) cvtpk_s(P[B],P[B+1])
  #define PAF(k) __builtin_bit_cast(bf16x8,pw##k)
  #define VFR(i) (bf16x8){vlo[i][0],vlo[i][1],vlo[i][2],vlo[i][3],vhi[i][0],vhi[i][1],vhi[i][2],vhi[i][3]}
  #define PIN(x) asm volatile("":"+v"(x))
  #define MX3(a,b,c) __builtin_fmaxf(__builtin_fmaxf((a),(b)),(c))
  #define GAPA(MF,A0,A1,A2,A3,W0,W1,PW) do{ MF; sacc+=A0; sacc+=A1; sacc+=A2; sacc+=A3; PIN(sacc); W0; W1; PIN(PW); SBAR(); }while(0)
  #define EX(v) __builtin_amdgcn_exp2f(v)
  #define GAPB(MF,X,B) do{ MF; X[B]=EX(X[B]); X[B+1]=EX(X[B+1]); X[B+2]=EX(X[B+2]); X[B+3]=EX(X[B+3]); PIN(X); SBAR(); }while(0)
  #define VRD(i) do{ vlo[i]=vtr(vp_+(((i)>>2)*4096+((i)&3)*1024)); vhi[i]=vtr(vp_+(((i)>>2)*4096+((i)&3)*1024+512)); }while(0)
  #define KRD(G,j) do{ if(G){ kload2(kf,kp0+sl_next,j); SBAR(); } }while(0)
  #define STEP(C0,C1,P0,P1,t,GK,GV,GL) do{ SBAR(); \
    const lds_cptr vp_=vp0+sl_prev; \
    VRD(0); SBAR(); float sacc=(P0[0]+P0[1]); \
    GAPA(C0=__builtin_amdgcn_mfma_f32_32x32x16_bf16(kf[0],qr[0],negm,0,0,0), P0[2],P0[3],P0[4],P0[5],     pw0[0]=PKW(P0,0), pw0[1]=PKW(P0,2), pw0); \
    VRD(4); SBAR(); GAPA(C1=__builtin_amdgcn_mfma_f32_32x32x16_bf16(kf[1],qr[0],negm,0,0,0), P0[6],P0[7],P0[8],P0[9],     pw0[2]=PKW(P0,4), pw0[3]=PKW(P0,6), pw0); \
    VRD(1); SBAR(); GAPA(C0=__builtin_amdgcn_mfma_f32_32x32x16_bf16(kf[2],qr[1],C0,0,0,0),   P0[10],P0[11],P0[12],P0[13], pw1[0]=PKW(P0,8), pw1[1]=PKW(P0,10), pw1); \
    VRD(5); SBAR(); GAPA(C1=__builtin_amdgcn_mfma_f32_32x32x16_bf16(kf[3],qr[1],C1,0,0,0),   P0[14],P0[15],P1[0],P1[1],   pw1[2]=PKW(P0,12),pw1[3]=PKW(P0,14), pw1); \
    VRD(2); SBAR(); GAPA(C0=__builtin_amdgcn_mfma_f32_32x32x16_bf16(kf[4],qr[2],C0,0,0,0),   P1[2],P1[3],P1[4],P1[5],     pw2[0]=PKW(P1,0), pw2[1]=PKW(P1,2), pw2); \
    VRD(6); SBAR(); GAPA(C1=__builtin_amdgcn_mfma_f32_32x32x16_bf16(kf[5],qr[2],C1,0,0,0),   P1[6],P1[7],P1[8],P1[9],     pw2[2]=PKW(P1,4), pw2[3]=PKW(P1,6), pw2); \
    VRD(3); SBAR(); GAPA(C0=__builtin_amdgcn_mfma_f32_32x32x16_bf16(kf[6],qr[3],C0,0,0,0),   P1[10],P1[11],P1[12],P1[13], pw3[0]=PKW(P1,8), pw3[1]=PKW(P1,10), pw3); \
    VRD(7); SBAR(); GAPA(C1=__builtin_amdgcn_mfma_f32_32x32x16_bf16(kf[7],qr[3],C1,0,0,0),   P1[14],P1[15],0.f,0.f,       pw3[2]=PKW(P1,12),pw3[3]=PKW(P1,14), pw3); \
    l_reg+=sacc; \
    if(GK){DMA_K((t)+3,sl_cur);} if(GV){DMA_V((t)+1,sl_next);} \
    CMASK(C0,C1,t); \
    { float a=MX3(C0[0],C0[1],C1[0]),b=MX3(C0[2],C0[3],C1[1]); a=MX3(a,C1[2],C1[3]); \
      _Pragma("unroll") for(int r=4;r<16;r+=4){a=MX3(a,C0[r],C0[r+1]);b=MX3(b,C0[r+2],C0[r+3]);a=MX3(a,C1[r],C1[r+1]);b=MX3(b,C1[r+2],C1[r+3]);} \
      float rm=__builtin_fmaxf(a,b); { auto rr=__builtin_amdgcn_permlane32_swap(__float_as_uint(rm),__float_as_uint(rm),false,false); rm=__builtin_fmaxf(__uint_as_float(rr[0]),__uint_as_float(rr[1])); } \
      resc=false; \
      if(__builtin_expect(__any(rm>(float)THRL),0)){ const float dl=__builtin_fmaxf(rm,0.f); mhat+=dl; \
        _Pragma("unroll") for(int r=0;r<16;++r){C0[r]-=dl;C1[r]-=dl;} \
        _Pragma("unroll") for(int r=0;r<16;++r)negm[r]=-mhat; asm volatile("":"+v"(negm)); \
        const float f=__builtin_amdgcn_exp2f(-dl); l_reg*=f; if(hi==0)wsf[r32]=f; resc=true; } } \
    SBAR(); \
    GAPB(o[0]=__builtin_amdgcn_mfma_f32_32x32x16_bf16(PAF(0),VFR(0),o[0],0,0,0), C0,0); \
    GAPB(o[1]=__builtin_amdgcn_mfma_f32_32x32x16_bf16(PAF(0),VFR(4),o[1],0,0,0), C0,4); \
    KRD(GL,0); GAPB(o[0]=__builtin_amdgcn_mfma_f32_32x32x16_bf16(PAF(1),VFR(1),o[0],0,0,0), C0,8); \
    KRD(GL,1); GAPB(o[1]=__builtin_amdgcn_mfma_f32_32x32x16_bf16(PAF(1),VFR(5),o[1],0,0,0), C0,12); \
    KRD(GL,2); GAPB(o[0]=__builtin_amdgcn_mfma_f32_32x32x16_bf16(PAF(2),VFR(2),o[0],0,0,0), C1,0); \
    KRD(GL,3); GAPB(o[1]=__builtin_amdgcn_mfma_f32_32x32x16_bf16(PAF(2),VFR(6),o[1],0,0,0), C1,4); \
    GAPB(o[0]=__builtin_amdgcn_mfma_f32_32x32x16_bf16(PAF(3),VFR(3),o[0],0,0,0), C1,8); \
    GAPB(o[1]=__builtin_amdgcn_mfma_f32_32x32x16_bf16(PAF(3),VFR(7),o[1],0,0,0), C1,12); \
    }while(0)
  int t=1;
  #undef CMASK
  #define CMASK(P0,P1,t) do{}while(0)
  for(;t+5<NT;t+=2){
    STEP(pB0,pB1,pA0,pA1,t,true,true,true);     WAIT_BAR(2); RESC(); ROT();
    STEP(pA0,pA1,pB0,pB1,t+1,true,true,true);   WAIT_BAR(2); RESC(); ROT();
  }
  #undef CMASK
  #define CMASK(P0,P1,t) do{}while(0)
  #define ENDW(tt) do{ if((tt)+3<NT){WAIT_BAR(2);} else if((tt)+2<NT){WAIT_BAR(1);} else {WAIT_BAR(0);} }while(0)
  for(;t+1<NT;t+=2){
    STEP(pB0,pB1,pA0,pA1,t,(t+3<NT),(t+1<NT),(t+1<NT));       ENDW(t);   RESC(); ROT();
    STEP(pA0,pA1,pB0,pB1,t+1,(t+4<NT),(t+2<NT),(t+2<NT));     ENDW(t+1); RESC(); ROT();
  }
  STEP(pB0,pB1,pA0,pA1,NT-1,false,false,false); RESC();
  { float sacc=pB0[0]+pB0[1]; _Pragma("unroll") for(int r=2;r<16;++r)sacc+=pB0[r]; _Pragma("unroll") for(int r=0;r<16;++r)sacc+=pB1[r]; l_reg+=sacc;
    pw0=(u32x4){PKW(pB0,0),PKW(pB0,2),PKW(pB0,4),PKW(pB0,6)};pw1=(u32x4){PKW(pB0,8),PKW(pB0,10),PKW(pB0,12),PKW(pB0,14)};pw2=(u32x4){PKW(pB1,0),PKW(pB1,2),PKW(pB1,4),PKW(pB1,6)};pw3=(u32x4){PKW(pB1,8),PKW(pB1,10),PKW(pB1,12),PKW(pB1,14)};
    SBAR(); pv(o,vb0+sl_cur,PAF(0),PAF(1),PAF(2),PAF(3)); }
  #undef PKW
  #undef PAF
  #undef VFR
  #undef PIN
  #undef MX3
  #undef GAPA
  #undef GAPB
  #undef EX
  #undef VRD
  #undef KRD
  #undef STEP
  #undef ENDW
  {auto rr=__builtin_amdgcn_permlane32_swap(__float_as_uint(l_reg),__float_as_uint(l_reg),false,false);l_reg=__uint_as_float(rr[0])+__uint_as_float(rr[1]);}
  if(hi==0)wsf[32+r32]=l_reg;asm volatile("s_waitcnt lgkmcnt(0)":::"memory");
  float rli[16];
  #pragma unroll
  for(int r=0;r<16;++r)rli[r]=__builtin_amdgcn_rcpf(wsf[32+crow(r,hi)]);
  bf16*Ow=Ob+(long)(wid*QBLK)*ldo;
  { bf16*stg=(bf16*)(shm+LDS_OST)+wid*2048;
    #pragma unroll
    for(int r=0;r<16;++r){const int orow=crow(r,hi);
      #pragma unroll
      for(int d0=0;d0<2;++d0)stg[orow*64+d0*32+r32]=__float2bfloat16(o[d0][r]*rli[r]);}
    asm volatile("s_waitcnt lgkmcnt(0)":::"memory");
    #pragma unroll
    for(int i=0;i<4;++i){const int row=i*8+(lane>>3),ch=lane&7; const u32x4 v=*(const u32x4*)(stg+row*64+ch*8); ATTN_STORE16(Ow+(long)row*ldo+ch*8,v);} }
  asm volatile("s_waitcnt lgkmcnt(0)\n\ts_barrier":::"memory");
  #undef DMA_K
  #undef DMA_V
  #undef CMASK
  #undef START
  #undef RESC
  #undef ROT
}
constexpr int ATTN_LDS_BYTES=LDS_BYTES;
#undef SBAR
#undef WAIT_BAR
}

#define GAS __attribute__((address_space(1)))
#define LAS __attribute__((address_space(3)))
typedef unsigned short bf16;
typedef unsigned v4u __attribute__((ext_vector_type(4)));
typedef float f32x4 __attribute__((ext_vector_type(4)));
typedef short bf16x8 __attribute__((ext_vector_type(8)));
typedef GAS unsigned gu32;
typedef GAS unsigned long long gu64;
#define RLX_AGENT __ATOMIC_RELAXED, __HIP_MEMORY_SCOPE_AGENT
#define LDS_WAIT() asm volatile("s_waitcnt lgkmcnt(0)" ::: "memory")
#define VM_WAIT() asm volatile("s_waitcnt vmcnt(0)" ::: "memory")
__device__ __forceinline__ unsigned long long rt() { return __builtin_amdgcn_s_memrealtime(); }
__device__ __forceinline__ unsigned f2bf(float f) { unsigned u = __builtin_bit_cast(unsigned, f); return (u + 0x7fffu + ((u >> 16) & 1u)) >> 16; }
__device__ __forceinline__ unsigned pk2(float lo, float hi) { return f2bf(lo) | (f2bf(hi) << 16); }

#define XB_TMO      128
#define XB_XCNT(j)  (256  + 64 * (j))
#define XB_XSUB(j)  (1280 + 64 * (j))
#define XB_XGEN(j)  (2304 + 64 * (j))
#define XB_TOP      3328
#define XB_TOPGEN   3392
#define XCD_BAR_WORDS 3456
#define XB_SPIN_CAP (1u << 18)

__device__ __forceinline__ unsigned xb_ld(unsigned* p)              { return __hip_atomic_load(p, __ATOMIC_RELAXED, __HIP_MEMORY_SCOPE_AGENT); }
__device__ __forceinline__ unsigned xb_add(unsigned* p, unsigned v) { return __hip_atomic_fetch_add(p, v, __ATOMIC_RELAXED, __HIP_MEMORY_SCOPE_AGENT); }
__device__ __forceinline__ unsigned xb_xcc_id() { return (unsigned)__builtin_amdgcn_s_getreg((3 << 11) | 20) & 0xFu; }
#define XB_SPIN(cond, bar) do { unsigned _sp = 0; while (cond) { __builtin_amdgcn_s_sleep(1); \
    if ((++_sp & 255u) == 0u) { if (xb_ld(&(bar)[XB_TMO])) break; if (_sp > XB_SPIN_CAP) { atomicAdd(&(bar)[XB_TMO], 1u); break; } } } } while (0)

struct XcdBarrier {
    unsigned* bar; unsigned x;
    volatile LAS unsigned* st;
};

__device__ __forceinline__ XcdBarrier xcd_barrier_post(unsigned* bar, volatile LAS unsigned* st) {
    XcdBarrier b; b.bar = bar; b.x = xb_xcc_id(); b.st = st;
    if (threadIdx.x == 0) (void)xb_add(&bar[XB_XCNT(b.x)], 1u);
    return b;
}
__device__ __forceinline__ void xcd_barrier_complete(unsigned* bar, unsigned x, unsigned& nloc, unsigned& nx) {
    const unsigned G = gridDim.x * gridDim.y * gridDim.z;
    unsigned sum, cnt, mine, sp = 0u;
    for (;;) {
        sum = 0u; cnt = 0u; mine = 0u;
#pragma unroll
        for (unsigned j = 0; j < 16; ++j) { const unsigned c = xb_ld(&bar[XB_XCNT(j)]); sum += c; cnt += (c > 0u) ? 1u : 0u; mine = (j == x) ? c : mine; }
        if (sum == G) break;
        __builtin_amdgcn_s_sleep(1);
        if ((++sp & 255u) == 0u) { if (xb_ld(&bar[XB_TMO])) break; if (sp > XB_SPIN_CAP) { atomicAdd(&bar[XB_TMO], 1u); break; } }
    }
    nloc = mine > 0u ? mine : 1u; nx = cnt > 0u ? cnt : 1u;
}

__device__ __forceinline__ void xcd_barrier(const XcdBarrier& b) {
    asm volatile("s_waitcnt vmcnt(0)" ::: "memory");
    __syncthreads();
    if (threadIdx.x == 0) {
        unsigned* bar = b.bar; unsigned xq = b.x; asm volatile("" : "+s"(bar), "+s"(xq));
        __builtin_amdgcn_s_waitcnt(0);
        unsigned nloc = b.st[0], nx = b.st[1];
        if (nloc == 0u) { xcd_barrier_complete(bar, xq, nloc, nx); b.st[0] = nloc; b.st[1] = nx; }
        const unsigned old = xb_add(&bar[XB_XSUB(xq)], 1u);
        const unsigned gen = old / nloc;
        if (old + 1u == (gen + 1u) * nloc) {
            __builtin_amdgcn_fence(__ATOMIC_RELEASE, "agent");
            asm volatile("s_waitcnt vmcnt(0)" ::: "memory");
            const unsigned og = xb_add(&bar[XB_TOP], 1u);
            const unsigned tg = og / nx;
            if (og + 1u == (tg + 1u) * nx) xb_add(&bar[XB_TOPGEN], 1u);
            else XB_SPIN(xb_ld(&bar[XB_TOPGEN]) == tg, bar);
            __builtin_amdgcn_fence(__ATOMIC_ACQUIRE, "agent");
            xb_add(&bar[XB_XGEN(xq)], 1u);
            asm volatile("s_waitcnt vmcnt(0)" ::: "memory");
        } else {
            XB_SPIN(xb_ld(&bar[XB_XGEN(xq)]) == gen, bar);
            __builtin_amdgcn_fence(__ATOMIC_ACQUIRE, "agent");
            asm volatile("s_waitcnt vmcnt(0)" ::: "memory");
        }
    }
    __syncthreads();
}

constexpr int NWAVES = 8, NTHR = 512;
constexpr int BATCH = 2, SEQ = 8192, DM = 1024, MROWS = BATCH * SEQ, DEPTH = 2;
constexpr int D_IN = 2576, NPROJ = 2560, DFF = 2816, NFF = 5632;
constexpr int P_MLQ = 0, P_MLK = 256, P_MLV = 512, P_MLO = 768, P_POOL = 1024, P_DQ = 1280, P_DK = 1536, P_DV = 1792, P_GQ = 2048, P_GK = 2304, P_GV = 2432;
constexpr float LOG2E = 1.4426950408889634f;
constexpr float C2D = 0.17677669529663687f * LOG2E;
constexpr float C2G = 0.125f * LOG2E;
constexpr float C2X = 0.0625f * LOG2E;
constexpr size_t MiB = 1u << 20;
constexpr size_t WS_CTL = 0, CTL_ZERO_BYTES = 1 * MiB;
constexpr size_t WS_ROPE = 1 * MiB;
constexpr size_t WS_SSQ = 2 * MiB;
constexpr size_t WS_HSSQ = 3 * MiB;
constexpr size_t WS_PSUM = 4 * MiB;
constexpr size_t WS_GATES = 5 * MiB;
constexpr size_t WS_MLSC = 6 * MiB;
constexpr size_t WS_NLOC = 7 * MiB;
constexpr size_t WS_MEMN = 8 * MiB;
constexpr size_t WS_KVRAW = 10 * MiB;
constexpr size_t WS_KM = 18 * MiB;
constexpr size_t WS_VMT = 20 * MiB;
constexpr size_t WS_W = 22 * MiB, W_LAYER = 32 * MiB;
constexpr size_t W_IN = 0, W_OUT = 5 * MiB, W_CQ = 7 * MiB, W_CKV = 9 * MiB, W_CO = 13 * MiB, W_FI = 15 * MiB, W_FO = 26 * MiB;
constexpr size_t WS_XB = 86 * MiB;
constexpr size_t WS_BIG = 118 * MiB;
constexpr size_t WS_PROJ = WS_BIG, WS_DQP = WS_BIG + 80 * MiB, WS_YCAT = WS_BIG + 96 * MiB;
constexpr size_t WS_CQ = WS_BIG, WS_PT = WS_BIG + 32 * MiB, WS_CO = WS_BIG + 64 * MiB;
constexpr size_t WS_ACT = WS_BIG;
constexpr size_t WS_END = 256 * MiB;
static_assert(WS_YCAT + 32 * MiB <= WS_END && WS_ACT + 88 * MiB <= WS_END, "d_ws map");
constexpr int CW_BAR = 4096;
constexpr int RING_OFF = 0, RING_BYTES = 131072;
constexpr int LDSCTL_OFF = RING_BYTES, MISC_OFF = LDSCTL_OFF + 320;
constexpr int LDS_BYTES = 147456;

typedef unsigned v2u __attribute__((ext_vector_type(2)));
typedef float f32x2 __attribute__((ext_vector_type(2)));
__device__ __forceinline__ float bflo(unsigned u) { return __uint_as_float(u << 16); }
__device__ __forceinline__ float bfhi(unsigned u) { return __uint_as_float(u & 0xffff0000u); }
__device__ __forceinline__ float bf1(bf16 u) { return __uint_as_float((unsigned)u << 16); }
__device__ __forceinline__ float wave_sum_(float v, int lane) {
#pragma unroll
    for (int o = 1; o < 64; o <<= 1) v += SHX(v, o);
    return v;
}
__device__ __forceinline__ float wave_max_(float v, int lane) {
#pragma unroll
    for (int o = 1; o < 64; o <<= 1) v = fmaxf(v, SHX(v, o));
    return v;
}
#define wave_sum(v) wave_sum_((v), lane)
#define wave_max(v) wave_max_((v), lane)
__device__ __forceinline__ float scan_add(float v, int lane) {
#pragma unroll
    for (int o = 1; o < 64; o <<= 1) { const float t = SHU(v, o); v = (lane >= o) ? v + t : v; }
    return v;
}
__device__ __forceinline__ float scan_max_up(float v, int lane) {
#pragma unroll
    for (int o = 1; o < 64; o <<= 1) { const float t = SHU(v, o); v = (lane >= o) ? fmaxf(v, t) : v; }
    return v;
}
__device__ __forceinline__ float scan_max_down(float v, int lane) {
#pragma unroll
    for (int o = 1; o < 64; o <<= 1) { const float t = SHD(v, o); v = (lane + o < 64) ? fmaxf(v, t) : v; }
    return v;
}
__device__ __forceinline__ float logsig(float x) { return fminf(x, 0.f) - log1pf(expf(-fabsf(x))); }

struct Args { const float* in[28]; float* out; unsigned char* ws; int ph_lo, ph_hi; };

__device__ __forceinline__ void tr_item(const float* W, int Nsrc, int K, int src_col0, bf16* WT, int dst_row0, const float* gk, float scale, LAS float* scr, int kb, int lane) {
    const int k0 = 64 * kb;
#pragma unroll 8
    for (int i = 0; i < 32; ++i) { const int kk = 2 * i + (lane >> 5); const float g = gk ? gk[k0 + kk] * scale : scale;
        scr[kk * 33 + (lane & 31)] = W[(size_t)(k0 + kk) * Nsrc + src_col0 + (lane & 31)] * g; }
    LDS_WAIT(); asm volatile("" ::: "memory");
    const int c = lane & 7;
#pragma unroll
    for (int j = 0; j < 4; ++j) { const int n = (lane >> 3) + 8 * j; const LAS float* s = scr + (8 * c) * 33 + n;
        v4u o; o.x = pk2(s[0 * 33], s[1 * 33]); o.y = pk2(s[2 * 33], s[3 * 33]); o.z = pk2(s[4 * 33], s[5 * 33]); o.w = pk2(s[6 * 33], s[7 * 33]);
        *(v4u*)(WT + (size_t)(dst_row0 + n) * K + k0 + 8 * c) = o; }
    LDS_WAIT(); asm volatile("" ::: "memory");
}
__device__ __forceinline__ void p0_prologue(const __attribute__((address_space(4))) Args* ap, LAS unsigned char* lds, int vcu, int G, int wave, int lane, int tid) {
    unsigned char* ws = ap->ws;
    LAS float* scr = (LAS float*)(lds + RING_OFF + wave * 16384);
    const int gw = vcu * NWAVES + wave, NGW = G * NWAVES;
    constexpr int I_IN = 16 * 80, I_OUT = 16 * 32, I_CQ = 16 * 32, I_CKV = 16 * 64, I_CO = 16 * 32, I_FI = 16 * 176, I_FO = 44 * 32;
    constexpr int I_LAYER = I_IN + I_OUT + I_CQ + I_CKV + I_CO + I_FI + I_FO;
    for (int it = gw; it < DEPTH * I_LAYER; it += NGW) {
        const int l = it / I_LAYER; int r = it % I_LAYER;
        unsigned char* wl = ws + WS_W + (size_t)l * W_LAYER;
        if (r < I_IN) { const int kb = r / 80, nb = r % 80, d0 = 32 * nb;
            tr_item(ap->in[3] + (size_t)l * 1024 * D_IN, D_IN, 1024, d0 + (d0 >= 1024 ? 16 : 0), (bf16*)(wl + W_IN), d0, ap->in[2] + l * 1024, (d0 >= 256 && d0 < 512) ? 0.125f : 1.0f, scr, kb, lane); continue; } r -= I_IN;
        if (r < I_OUT) { tr_item(ap->in[15] + (size_t)l * 1024 * 1024, 1024, 1024, 32 * (r % 32), (bf16*)(wl + W_OUT), 32 * (r % 32), nullptr, 1.0f, scr, r / 32, lane); continue; } r -= I_OUT;
        if (r < I_CQ) { tr_item(ap->in[18] + (size_t)l * 1024 * 1024, 1024, 1024, 32 * (r % 32), (bf16*)(wl + W_CQ), 32 * (r % 32), ap->in[16] + l * 1024, 1.0f, scr, r / 32, lane); continue; } r -= I_CQ;
        if (r < I_CKV) { tr_item(ap->in[19] + (size_t)l * 1024 * 2048, 2048, 1024, 32 * (r % 64), (bf16*)(wl + W_CKV), 32 * (r % 64), nullptr, 1.0f, scr, r / 64, lane); continue; } r -= I_CKV;
        if (r < I_CO) { tr_item(ap->in[22] + (size_t)l * 1024 * 1024, 1024, 1024, 32 * (r % 32), (bf16*)(wl + W_CO), 32 * (r % 32), nullptr, 1.0f, scr, r / 32, lane); continue; } r -= I_CO;
        if (r < I_FI) { const int kb = r / 176, nb = r % 176, d0 = 32 * nb, tile = d0 >> 8, within = d0 & 255;
            const int src = within < 128 ? 128 * tile + within : DFF + 128 * tile + (within - 128);
            tr_item(ap->in[24] + (size_t)l * 1024 * NFF, NFF, 1024, src, (bf16*)(wl + W_FI), d0, ap->in[23] + l * 1024, 1.0f, scr, kb, lane); continue; } r -= I_FI;
        tr_item(ap->in[27] + (size_t)l * DFF * 1024, 1024, DFF, 32 * (r % 32), (bf16*)(wl + W_FO), 32 * (r % 32), nullptr, 1.0f, scr, r / 32, lane);
    }
    { const float* x = ap->in[0]; bf16* XB = (bf16*)(ws + WS_XB); float* SSQ = (float*)(ws + WS_SSQ);
      for (int m = gw; m < MROWS; m += NGW) { const f32x4* xr = (const f32x4*)(x + (size_t)m * DM) + lane; float s = 0.f;
          unsigned long long* o8 = (unsigned long long*)(XB + (size_t)m * DM) + lane;
#pragma unroll
          for (int j = 0; j < 4; ++j) { const f32x4 v = xr[64 * j]; s += (v[0] * v[0] + v[1] * v[1]) + (v[2] * v[2] + v[3] * v[3]);
              o8[64 * j] = (unsigned long long)pk2(v[0], v[1]) | ((unsigned long long)pk2(v[2], v[3]) << 32); }
          s = wave_sum(s); if (lane < 16) SSQ[(size_t)m * 16 + lane] = (lane == 0) ? s : 0.f; } }
    { const float* mem = ap->in[1]; bf16* MEMN = (bf16*)(ws + WS_MEMN);
      for (int idx = gw; idx < DEPTH * 512; idx += NGW) { const int l = idx >> 9, r = idx & 511; const f32x4* xr = (const f32x4*)(mem + (size_t)r * DM) + lane; const f32x4* gr = (const f32x4*)(ap->in[17] + l * DM) + lane;
          f32x4 v[4]; float s = 0.f;
#pragma unroll
          for (int j = 0; j < 4; ++j) { v[j] = xr[64 * j]; s += (v[j][0] * v[j][0] + v[j][1] * v[j][1]) + (v[j][2] * v[j][2] + v[j][3] * v[j][3]); }
          const float rs = 1.0f / sqrtf(wave_sum(s) * (1.0f / 1024.0f) + 1e-6f);
          unsigned long long* o8 = (unsigned long long*)(MEMN + (size_t)idx * DM) + lane;
#pragma unroll
          for (int j = 0; j < 4; ++j) { const f32x4 g = gr[64 * j]; o8[64 * j] = (unsigned long long)pk2(v[j][0] * rs * g[0], v[j][1] * rs * g[1]) | ((unsigned long long)pk2(v[j][2] * rs * g[2], v[j][3] * rs * g[3]) << 32); } } }
    { float2* RT = (float2*)(ws + WS_ROPE);
      for (int e = vcu * NTHR + tid; e < SEQ * 16; e += G * NTHR) { const int pos = e >> 4, i = e & 15;
          double inv = 1.0; for (int q = 0; q < i; ++q) inv *= 0.56234132519034908;
          const double rev = (double)pos * inv * 0.15915494309189535; double fr = rev - floor(rev); if (fr > 0.5) fr -= 1.0;
          const float ang = (float)(fr * 6.283185307179586);
          RT[e] = make_float2(cosf(ang), sinf(ang)); } }
}

__device__ __forceinline__ void gates_phase(const float* x, const float* Win, const float* gmix, float* GATES, LAS unsigned char* lds, int vcu, int G, int wave, int lane, int tid) {
    LAS float* WG = (LAS float*)(lds + RING_OFF);
    for (int e = tid; e < 16384; e += NTHR) { const int k = e >> 4, j = e & 15; WG[j * 1024 + k] = Win[(size_t)k * D_IN + 1024 + j] * gmix[k]; }
    __syncthreads();
    const int gw = vcu * NWAVES + wave, NGW = G * NWAVES;
    for (int t = gw; t < MROWS; t += NGW) {
        const float* xr = x + (size_t)t * DM + lane; float acc[16]; float ss = 0.f;
#pragma unroll
        for (int j = 0; j < 16; ++j) acc[j] = 0.f;
#pragma unroll 4
        for (int i = 0; i < 16; ++i) { const float xv = xr[64 * i]; ss += xv * xv; const LAS float* w = WG + 64 * i + lane;
#pragma unroll
            for (int j = 0; j < 16; ++j) acc[j] += xv * w[j * 1024]; }
        const float rs = 1.0f / sqrtf(wave_sum(ss) * (1.0f / 1024.0f) + 1e-6f); float outv = 0.f;
#pragma unroll
        for (int j = 0; j < 16; ++j) { const float tot = wave_sum(acc[j]); outv = (lane == j) ? tot : outv; }
        if (lane < 16) GATES[(size_t)t * 16 + lane] = outv * rs;
    }
    __syncthreads();
}

__device__ __forceinline__ void qk_post_token(int t, bf16* PROJ, bf16* DQP, const float2* RT, const float* dqn, const float* dkn, const float* gqn, const float* gkn, int lane) {
    const int pos = t & (SEQ - 1), prow = pos >> 6, pcol = pos & 63;
    bf16* pr = PROJ + (size_t)t * NPROJ;
    {
        const int grp = lane >> 3, i = 2 * (lane & 7);
        const float2 cs0 = RT[pos * 16 + i], cs1 = RT[pos * 16 + i + 1];
#pragma unroll
        for (int which = 0; which < 2; ++which) {
            bf16* p = pr + (which ? P_DK : P_DQ) + grp * 32; const float* gn = which ? dkn : dqn;
            const unsigned ua = *(const unsigned*)(p + i), ub = *(const unsigned*)(p + 16 + i);
            float x1a = bflo(ua), x1b = bfhi(ua), x2a = bflo(ub), x2b = bfhi(ub);
            float ss = (x1a * x1a + x1b * x1b) + (x2a * x2a + x2b * x2b); ss += SHX(ss, 1); ss += SHX(ss, 2); ss += SHX(ss, 4);
            const float r = 1.0f / sqrtf(ss * (1.0f / 32.0f) + 1e-6f);
            x1a *= r * gn[i]; x1b *= r * gn[i + 1]; x2a *= r * gn[16 + i]; x2b *= r * gn[17 + i];
            float y1a = x1a * cs0.x - x2a * cs0.y, y2a = x2a * cs0.x + x1a * cs0.y, y1b = x1b * cs1.x - x2b * cs1.y, y2b = x2b * cs1.x + x1b * cs1.y;
            if (which == 0) { bf16* q = DQP + (size_t)t * 512 + grp * 64; const int qo = (grp & 1) * 32, zo = 32 - qo;
                *(unsigned*)(q + qo + i) = pk2(y1a * C2D, y1b * C2D); *(unsigned*)(q + qo + 16 + i) = pk2(y2a * C2D, y2b * C2D);
                *(unsigned long long*)(q + zo + 4 * (lane & 7)) = 0ull; }
            else { *(unsigned*)(p + i) = pk2(y1a, y1b); *(unsigned*)(p + 16 + i) = pk2(y2a, y2b); }
        }
    }
    {
        const int head = lane >> 4, sub = lane & 15, half = sub >> 3, i = 2 * (sub & 7);
        const int pp = half ? pcol : prow; const float2 cs0 = RT[pp * 16 + i], cs1 = RT[pp * 16 + i + 1];
        bf16* p = pr + P_GQ + head * 64 + half * 32; const float* gn = gqn + half * 32;
        const unsigned ua = *(const unsigned*)(p + i), ub = *(const unsigned*)(p + 16 + i);
        float x1a = bflo(ua), x1b = bfhi(ua), x2a = bflo(ub), x2b = bfhi(ub);
        float ss = (x1a * x1a + x1b * x1b) + (x2a * x2a + x2b * x2b); ss += SHX(ss, 1); ss += SHX(ss, 2); ss += SHX(ss, 4); ss += SHX(ss, 8);
        const float r = C2G / sqrtf(ss * (1.0f / 64.0f) + 1e-6f);
        x1a *= r * gn[i]; x1b *= r * gn[i + 1]; x2a *= r * gn[16 + i]; x2b *= r * gn[17 + i];
        *(unsigned*)(p + i) = pk2(x1a * cs0.x - x2a * cs0.y, x1b * cs1.x - x2b * cs1.y); *(unsigned*)(p + 16 + i) = pk2(x2a * cs0.x + x1a * cs0.y, x2b * cs1.x + x1b * cs1.y);
    }
    {
        const int head = lane >> 5, sub = lane & 31, half = sub >> 4, i = sub & 15;
        const int pp = half ? pcol : prow; const float2 cs = RT[pp * 16 + i];
        bf16* p = pr + P_GK + head * 64 + half * 32; const float* gn = gkn + half * 32;
        float x1 = bf1(p[i]), x2 = bf1(p[16 + i]);
        float ss = x1 * x1 + x2 * x2; ss += SHX(ss, 1); ss += SHX(ss, 2); ss += SHX(ss, 4); ss += SHX(ss, 8); ss += SHX(ss, 16);
        const float r = 1.0f / sqrtf(ss * (1.0f / 64.0f) + 1e-6f);
        x1 *= r * gn[i]; x2 *= r * gn[16 + i];
        p[i] = (bf16)f2bf(x1 * cs.x - x2 * cs.y); p[16 + i] = (bf16)f2bf(x2 * cs.x + x1 * cs.y);
    }
}
__device__ __forceinline__ void pool_item(LAS unsigned char* lds, int item, const bf16* PROJ, const float* pw, const float* pscale, bf16* YCAT, int tid) {
    const int tile = item >> 2, g = item & 3, win = 2 << g;
    const int trow0 = tile * 64, pos0 = trow0 & (SEQ - 1);
    LAS float* U = (LAS float*)lds;
    LAS float* PT_ = U + 80 * 64;
    LAS float* Wg = PT_ + 4096;
    for (int e = tid; e < 640; e += NTHR) { const int jj = e >> 3, c8 = (e & 7) * 8; const int p = pos0 - 8 + jj;
        v4u raw = (v4u){0u, 0u, 0u, 0u};
        if (p >= 0 && p < SEQ) raw = *(const v4u*)(PROJ + (size_t)(trow0 - 8 + jj) * NPROJ + P_POOL + g * 64 + c8);
        LAS float* d = U + jj * 64 + c8; d[0] = bflo(raw.x); d[1] = bfhi(raw.x); d[2] = bflo(raw.y); d[3] = bfhi(raw.y); d[4] = bflo(raw.z); d[5] = bfhi(raw.z); d[6] = bflo(raw.w); d[7] = bfhi(raw.w); }
    for (int e = tid; e < 1024; e += NTHR) *(LAS f32x4*)(Wg + 4 * e) = *(const f32x4*)(pw + g * 4096 + 4 * e);
    __syncthreads();
    { const int tl = tid >> 3, c8 = (tid & 7) * 8, pos = pos0 + tl;
      int lo = pos - win / 2, hi = pos - win / 2 + win - 1; lo = lo < 0 ? 0 : lo; hi = hi > SEQ - 1 ? SEQ - 1 : hi;
      float s[8];
#pragma unroll
      for (int q = 0; q < 8; ++q) s[q] = 0.f;
      for (int p = lo; p <= hi; ++p) { const LAS float* u = U + (p - pos0 + 8) * 64 + c8;
#pragma unroll
          for (int q = 0; q < 8; ++q) s[q] += u[q]; }
      const float inv = 1.0f / (float)(hi - lo + 1); const LAS float* uc = U + (tl + 8) * 64 + c8;
#pragma unroll
      for (int q = 0; q < 8; ++q) PT_[(c8 + q) * 64 + tl] = s[q] * inv - uc[q]; }
    __syncthreads();
    { const int t0 = (tid >> 4) * 2, e0 = (tid & 15) * 4; float acc[2][4];
#pragma unroll
      for (int i = 0; i < 2; ++i)
#pragma unroll
          for (int j = 0; j < 4; ++j) acc[i][j] = 0.f;
      for (int c = 0; c < 64; ++c) { const f32x2 pp = *(const LAS f32x2*)(PT_ + c * 64 + t0); const f32x4 ww = *(const LAS f32x4*)(Wg + c * 64 + e0);
#pragma unroll
          for (int i = 0; i < 2; ++i)
#pragma unroll
              for (int j = 0; j < 4; ++j) acc[i][j] += pp[i] * ww[j]; }
      const f32x4 sc = *(const f32x4*)(pscale + g * 64 + e0);
#pragma unroll
      for (int i = 0; i < 2; ++i) { v2u w; w.x = pk2(acc[i][0] * sc[0], acc[i][1] * sc[1]); w.y = pk2(acc[i][2] * sc[2], acc[i][3] * sc[3]);
          *(v2u*)(YCAT + (size_t)(trow0 + t0 + i) * DM + 256 + g * 64 + e0) = w; } }
    __syncthreads();
}
__device__ __forceinline__ void ml_gates(const float* GATES, const float* bi, const float* bfz, int trow0, int h, int lane, float& lfF, float& liF, float& lfB, float& liB) {
    const float* g = GATES + (size_t)(trow0 + lane) * 16;
    liF = g[h] + bi[h]; lfF = logsig(g[4 + h] + bfz[h]); liB = g[8 + h] + bi[4 + h]; lfB = logsig(g[12 + h] + bfz[4 + h]);
}
__device__ __forceinline__ void load_tile_T(LAS float* dstT, const bf16* src, int tid) {
    const int r = tid >> 3, c8 = (tid & 7) * 8; const v4u raw = *(const v4u*)(src + (size_t)r * NPROJ + c8);
    dstT[(c8 + 0) * 64 + r] = bflo(raw.x); dstT[(c8 + 1) * 64 + r] = bfhi(raw.x); dstT[(c8 + 2) * 64 + r] = bflo(raw.y); dstT[(c8 + 3) * 64 + r] = bfhi(raw.y);
    dstT[(c8 + 4) * 64 + r] = bflo(raw.z); dstT[(c8 + 5) * 64 + r] = bfhi(raw.z); dstT[(c8 + 6) * 64 + r] = bflo(raw.w); dstT[(c8 + 7) * 64 + r] = bfhi(raw.w);
}
__device__ __forceinline__ void load_tile(LAS float* dst, const bf16* src, int tid) {
    const int r = tid >> 3, c8 = (tid & 7) * 8; const v4u raw = *(const v4u*)(src + (size_t)r * NPROJ + c8); LAS float* d = dst + r * 64 + c8;
    d[0] = bflo(raw.x); d[1] = bfhi(raw.x); d[2] = bflo(raw.y); d[3] = bfhi(raw.y); d[4] = bflo(raw.z); d[5] = bfhi(raw.z); d[6] = bflo(raw.w); d[7] = bfhi(raw.w);
}
__device__ __forceinline__ void ml_local_item(LAS unsigned char* lds, int item, const bf16* PROJ, const float* GATES, const float* bi, const float* bfz, float* CLOC, float* NLOC, float* GG, float* MLOC, int tid) {
    const int b = item >> 9, h = (item >> 7) & 3, c = item & 127, trow0 = b * SEQ + c * 64, lane = tid & 63, wave = tid >> 6;
    LAS float* kS = (LAS float*)lds; LAS float* vS = kS + 4096; LAS float* wS = vS + 4096;
    const int seqF = (b * 4 + h) * 2;
    load_tile(kS, PROJ + (size_t)trow0 * NPROJ + P_MLK + h * 64, tid); load_tile(vS, PROJ + (size_t)trow0 * NPROJ + P_MLV + h * 64, tid);
    if (wave == 0) { float lfF, liF, lfB, liB; ml_gates(GATES, bi, bfz, trow0, h, lane, lfF, liF, lfB, liB);
        const float bF = scan_add(lfF, lane), gF = SHI(bF, 63), aF = gF - bF + liF, mF = wave_max(aF);
        const float pB = scan_add(lfB, lane), gB = SHI(pB, 63), bB = gB - pB + lfB, aB = gB - bB + liB, mB = wave_max(aB);
        wS[2 * lane] = expf(aF - mF); wS[2 * lane + 1] = expf(aB - mB);
        if (lane == 0) { GG[seqF * 128 + c] = gF; MLOC[seqF * 128 + c] = mF; GG[(seqF + 1) * 128 + c] = gB; MLOC[(seqF + 1) * 128 + c] = mB; } }
    __syncthreads();
    const int d0 = (tid >> 4) * 2, e0 = (tid & 15) * 4; float aF[2][4], aB[2][4], nF[2] = {0.f, 0.f}, nB[2] = {0.f, 0.f};
#pragma unroll
    for (int i = 0; i < 2; ++i)
#pragma unroll
        for (int j = 0; j < 4; ++j) { aF[i][j] = 0.f; aB[i][j] = 0.f; }
#pragma unroll 4
    for (int s = 0; s < 64; ++s) { const f32x2 w = *(const LAS f32x2*)(wS + 2 * s), kk = *(const LAS f32x2*)(kS + s * 64 + d0); const f32x4 vv = *(const LAS f32x4*)(vS + s * 64 + e0);
#pragma unroll
        for (int i = 0; i < 2; ++i) { const float kf = kk[i] * w[0], kb = kk[i] * w[1]; nF[i] += kf; nB[i] += kb;
#pragma unroll
            for (int j = 0; j < 4; ++j) { aF[i][j] += kf * vv[j]; aB[i][j] += kb * vv[j]; } } }
#pragma unroll
    for (int i = 0; i < 2; ++i) {
        *(f32x4*)(CLOC + ((size_t)(seqF * 128 + c) * 4096 + (d0 + i) * 64 + e0)) = (f32x4){aF[i][0], aF[i][1], aF[i][2], aF[i][3]};
        *(f32x4*)(CLOC + ((size_t)((seqF + 1) * 128 + c) * 4096 + (d0 + i) * 64 + e0)) = (f32x4){aB[i][0], aB[i][1], aB[i][2], aB[i][3]};
        if ((tid & 15) == 0) { NLOC[(size_t)(seqF * 128 + c) * 64 + d0 + i] = nF[i]; NLOC[(size_t)((seqF + 1) * 128 + c) * 64 + d0 + i] = nB[i]; } }
    __syncthreads();
}
__device__ __forceinline__ void mem_post_row(int idx, const float* KVRAW, const float* cqn, const float* ckn, bf16* KM, bf16* VMT, int lane) {
    const int l = idx >> 9, r = idx & 511, b = r >> 8, key = r & 255; const float* raw = KVRAW + (size_t)idx * 2048;
    const f32x4 gq = *(const f32x4*)(cqn + l * 256 + 4 * lane), gk = *(const f32x4*)(ckn + l * 256 + 4 * lane);
#pragma unroll
    for (int h = 0; h < 4; ++h) { const f32x4 k4 = *(const f32x4*)(raw + h * 256 + 4 * lane);
        const float ss = wave_sum((k4[0] * k4[0] + k4[1] * k4[1]) + (k4[2] * k4[2] + k4[3] * k4[3])); const float rr = C2X / sqrtf(ss * (1.0f / 256.0f) + 1e-6f);
        v2u w; w.x = pk2(k4[0] * rr * gk[0] * gq[0], k4[1] * rr * gk[1] * gq[1]); w.y = pk2(k4[2] * rr * gk[2] * gq[2], k4[3] * rr * gk[3] * gq[3]);
        const size_t hb = (size_t)((l * 2 + b) * 4 + h) * 65536;
        *(v2u*)(KM + hb + (size_t)key * 256 + 4 * lane) = w;
        const f32x4 v4 = *(const f32x4*)(raw + 1024 + h * 256 + 4 * lane);
#pragma unroll
        for (int j = 0; j < 4; ++j) VMT[hb + (size_t)(4 * lane + j) * 256 + key] = (bf16)f2bf(v4[j]); }
}
__device__ __forceinline__ void ml_scan(float* CLOC, float* NLOC, const float* GG, const float* MLOC, float* MPREV, int gw, int NGW, int lane) {
    for (int w = gw; w < 16 * 65; w += NGW) {
        const int seq = w / 65, part = w % 65; const bool bwd = (seq & 1) != 0;
        float* base = part < 64 ? CLOC + (size_t)seq * 128 * 4096 + part * 64 + lane : NLOC + (size_t)seq * 128 * 64 + lane;
        const size_t cs = part < 64 ? 4096 : 64;
        float C = 0.f, m = 0.f;
        for (int c8 = 0; c8 < 128; c8 += 8) {
            float loc[8], gg[8], ml[8];
#pragma unroll
            for (int j = 0; j < 8; ++j) { const int c = bwd ? 127 - (c8 + j) : c8 + j; loc[j] = base[(size_t)c * cs]; gg[j] = GG[seq * 128 + c]; ml[j] = MLOC[seq * 128 + c]; }
#pragma unroll
            for (int j = 0; j < 8; ++j) { const int c = bwd ? 127 - (c8 + j) : c8 + j;
                base[(size_t)c * cs] = C; if (part == 64 && lane == 0) MPREV[seq * 128 + c] = m;
                const float mn = fmaxf(gg[j] + m, ml[j]); const float fo = expf(gg[j] + m - mn), fl = expf(ml[j] - mn); C = fo * C + fl * loc[j]; m = mn; }
        }
    }
}
__device__ __forceinline__ void ml_out_item(LAS unsigned char* lds, int item, const bf16* PROJ, const float* GATES, const float* bi, const float* bfz, const float* CLOC, const float* NLOC, const float* MPREV, const float* gnorm, bf16* YCAT, int tid) {
    const int b = item >> 9, h = (item >> 7) & 3, c = item & 127, trow0 = b * SEQ + c * 64, lane = tid & 63, wave = tid >> 6;
    LAS float* qT = (LAS float*)lds; LAS float* kT = qT + 4096; LAS float* vS = kT + 4096; LAS float* CpS = vS + 4096; LAS float* WT = CpS + 4096;
    LAS float* VB = WT + 4096;
    LAS float* VLI = VB + 128;
    LAS float* MT = VLI + 128; LAS float* SI = MT + 64; LAS float* NP = SI + 64;
    const bf16* prow = PROJ + (size_t)trow0 * NPROJ;
    load_tile_T(qT, prow + P_MLQ + h * 64, tid); load_tile_T(kT, prow + P_MLK + h * 64, tid); load_tile(vS, prow + P_MLV + h * 64, tid);
    if (wave == 0) { float lfF, liF, lfB, liB; ml_gates(GATES, bi, bfz, trow0, h, lane, lfF, liF, lfB, liB);
        const float bF = scan_add(lfF, lane); const float pB = scan_add(lfB, lane), gB = SHI(pB, 63), bB = gB - pB + lfB;
        VB[lane] = bF; VB[64 + lane] = bB; VLI[lane] = liF; VLI[64 + lane] = liB; }
    const int t0 = (tid >> 4) * 2, x0 = (tid & 15) * 4;
    float hacc[2][4];
#pragma unroll
    for (int i = 0; i < 2; ++i)
#pragma unroll
        for (int j = 0; j < 4; ++j) hacc[i][j] = 0.f;
    __syncthreads();
    for (int dir = 0; dir < 2; ++dir) {
        const int seq = (b * 4 + h) * 2 + dir; const size_t sc = (size_t)seq * 128 + c;
        { const f32x4* src = (const f32x4*)(CLOC + sc * 4096); *(LAS f32x4*)(CpS + 4 * tid) = src[tid]; *(LAS f32x4*)(CpS + 4 * (tid + 512)) = src[tid + 512]; }
        if (tid < 64) NP[tid] = NLOC[sc * 64 + tid];
        if (wave == 0) { const float mprev = MPREV[sc]; const float bt = VB[dir * 64 + lane], u = VLI[dir * 64 + lane] - bt;
            const float pm = dir ? scan_max_down(u, lane) : scan_max_up(u, lane);
            const float e = bt + mprev, mt = fmaxf(e, bt + pm); MT[lane] = mt; SI[lane] = expf(e - mt); }
        __syncthreads();
        {
            float acc[2][4];
#pragma unroll
            for (int i = 0; i < 2; ++i)
#pragma unroll
                for (int j = 0; j < 4; ++j) acc[i][j] = 0.f;
#pragma unroll 4
            for (int d = 0; d < 64; ++d) { const f32x2 qq = *(const LAS f32x2*)(qT + d * 64 + t0); const f32x4 kk = *(const LAS f32x4*)(kT + d * 64 + x0);
#pragma unroll
                for (int i = 0; i < 2; ++i)
#pragma unroll
                    for (int j = 0; j < 4; ++j) acc[i][j] += qq[i] * kk[j]; }
#pragma unroll
            for (int j = 0; j < 4; ++j) { const int s = x0 + j; const float us = VLI[dir * 64 + s] - VB[dir * 64 + s]; f32x2 w;
#pragma unroll
                for (int i = 0; i < 2; ++i) { const int t = t0 + i; const bool ok = dir ? (s >= t) : (s <= t);
                    w[i] = ok ? expf(VB[dir * 64 + t] + us - MT[t]) * acc[i][j] : 0.f; }
                *(LAS f32x2*)(WT + s * 64 + t0) = w; }
        }
        __syncthreads();
        {
            float num[2][4], den[2] = {0.f, 0.f}, inter[2][4], qn[2] = {0.f, 0.f};
#pragma unroll
            for (int i = 0; i < 2; ++i)
#pragma unroll
                for (int j = 0; j < 4; ++j) { num[i][j] = 0.f; inter[i][j] = 0.f; }
#pragma unroll 4
            for (int s = 0; s < 64; ++s) { const f32x2 ww = *(const LAS f32x2*)(WT + s * 64 + t0); const f32x4 vv = *(const LAS f32x4*)(vS + s * 64 + x0);
#pragma unroll
                for (int i = 0; i < 2; ++i) { den[i] += ww[i];
#pragma unroll
                    for (int j = 0; j < 4; ++j) num[i][j] += ww[i] * vv[j]; } }
#pragma unroll 4
            for (int d = 0; d < 64; ++d) { const f32x2 qq = *(const LAS f32x2*)(qT + d * 64 + t0); const f32x4 cc = *(const LAS f32x4*)(CpS + d * 64 + x0); const float np = NP[d];
#pragma unroll
                for (int i = 0; i < 2; ++i) { qn[i] += qq[i] * np;
#pragma unroll
                    for (int j = 0; j < 4; ++j) inter[i][j] += qq[i] * cc[j]; } }
#pragma unroll
            for (int i = 0; i < 2; ++i) { const float si = SI[t0 + i], mt = MT[t0 + i]; const float dn = fmaxf(fabsf(den[i] + si * qn[i]), expf(-mt)); const float inv = 1.0f / dn;
#pragma unroll
                for (int j = 0; j < 4; ++j) hacc[i][j] += (num[i][j] + si * inter[i][j]) * inv; }
        }
        __syncthreads();
    }
    const f32x4 gn = *(const f32x4*)(gnorm + h * 64 + x0);
#pragma unroll
    for (int i = 0; i < 2; ++i) { float ss = (hacc[i][0] * hacc[i][0] + hacc[i][1] * hacc[i][1]) + (hacc[i][2] * hacc[i][2] + hacc[i][3] * hacc[i][3]);
        ss += SHX(ss, 1); ss += SHX(ss, 2); ss += SHX(ss, 4); ss += SHX(ss, 8);
        const float r = 1.0f / sqrtf(ss * (1.0f / 64.0f) + 1e-6f);
        const v2u og = *(const v2u*)(prow + (size_t)(t0 + i) * NPROJ + P_MLO + h * 64 + x0);
        const float o0 = bflo(og.x), o1 = bfhi(og.x), o2 = bflo(og.y), o3 = bfhi(og.y);
        const float y0 = hacc[i][0] * r * gn[0] / (1.0f + expf(-o0)), y1 = hacc[i][1] * r * gn[1] / (1.0f + expf(-o1)), y2 = hacc[i][2] * r * gn[2] / (1.0f + expf(-o2)), y3 = hacc[i][3] * r * gn[3] / (1.0f + expf(-o3));
        v2u w; w.x = pk2(y0, y1); w.y = pk2(y2, y3); *(v2u*)(YCAT + (size_t)(trow0 + t0 + i) * DM + h * 64 + x0) = w; }
    __syncthreads();
}
__device__ __forceinline__ void diff_combine(const bf16* DQP, const float* lamp, const float* gsub, float lam_init, bf16* YCAT, int gw, int NGW, int lane) {
    float p1 = 0.f, p2 = 0.f; if (lane < 32) { p1 = lamp[lane] * lamp[32 + lane]; p2 = lamp[64 + lane] * lamp[96 + lane]; }
    const float lam = expf(wave_sum(p1)) - expf(wave_sum(p2)) + lam_init;
    const int head = lane >> 4, d4 = (lane & 15) * 4; const f32x4 g = *(const f32x4*)(gsub + d4); const float post = 1.0f - lam_init;
    for (int t = gw; t < MROWS; t += NGW) { const bf16* p = DQP + (size_t)t * 512 + head * 128 + d4; const v2u a = *(const v2u*)p, bq = *(const v2u*)(p + 64);
        const float x0 = bflo(a.x) - lam * bflo(bq.x), x1 = bfhi(a.x) - lam * bfhi(bq.x), x2 = bflo(a.y) - lam * bflo(bq.y), x3 = bfhi(a.y) - lam * bfhi(bq.y);
        float ss = (x0 * x0 + x1 * x1) + (x2 * x2 + x3 * x3); ss += SHX(ss, 1); ss += SHX(ss, 2); ss += SHX(ss, 4); ss += SHX(ss, 8);
        const float r = post / sqrtf(ss * (1.0f / 64.0f) + 1e-6f);
        v2u w; w.x = pk2(x0 * r * g[0], x1 * r * g[1]); w.y = pk2(x2 * r * g[2], x3 * r * g[3]); *(v2u*)(YCAT + (size_t)t * DM + 512 + head * 64 + d4) = w; }
}

typedef const __attribute__((address_space(4))) Args* KArgs;
__device__ __forceinline__ KArgs kargs() { KArgs p = (KArgs)__builtin_amdgcn_kernarg_segment_ptr(); asm volatile("" : "+s"(p)); return p; }
#define WSP(T, off) ((T*)(ws + (off)))
#define LTID int tid_l; asm volatile("v_mbcnt_lo_u32_b32 %0, -1, 0\n\tv_mbcnt_hi_u32_b32 %0, -1, %0" : "=v"(tid_l)); tid_l += wv * 64; const int tid = tid_l
__global__ void __launch_bounds__(NTHR, 2) hybrid_fwd(Args args_unused) {
    extern __shared__ __attribute__((aligned(16))) unsigned char lds_raw[];
    LAS unsigned char* lds = (LAS unsigned char*)lds_raw;
    const int wv = __builtin_amdgcn_readfirstlane((int)threadIdx.x >> 6);
    const int G = gridDim.x; const int bx = blockIdx.x; const int vcu = (G % 8 == 0) ? (bx % 8) * (G / 8) + bx / 8 : bx;
    { LTID; for (int u = tid; u < (LDS_BYTES - LDSCTL_OFF) / 4; u += NTHR) ((LAS unsigned*)(lds + LDSCTL_OFF))[u] = 0u; }
    __syncthreads();
    XcdBarrier bar = xcd_barrier_post((unsigned*)((gu32*)(kargs()->ws + WS_CTL) + CW_BAR), (volatile LAS unsigned*)(lds + MISC_OFF) + 8);
    const int lo = kargs()->ph_lo, hi = kargs()->ph_hi;
#define IN(k) (lo <= (k) && (k) < hi)
#ifndef PHMASK
#define PHMASK 0xFFFF
#endif
#define PHON(k) (((PHMASK) >> (k)) & 1)
#define SEAM(k) do { if (IN(k) && IN((k) + 1)) xcd_barrier(bar); } while (0)
#define WAVE_IDS LTID; const int lane = tid & 63, wave = __builtin_amdgcn_readfirstlane(tid >> 6), gw = vcu * NWAVES + wave, NGW = G * NWAVES; (void)lane; (void)gw; (void)NGW

    if (PHON(12) && IN(0)) { { WAVE_IDS; p0_prologue(kargs(), lds, vcu, G, wave, lane, tid); } if (IN(1)) { __threadfence(); cg::this_grid().sync(); } }

#pragma unroll 1
    for (int l = 0; l < DEPTH; ++l) {
        const int P = 1 + 12 * l;
        if (PHON(0) && IN(P + 0)) {
            if (l == 0) {
#pragma unroll 1
                for (int ll = 0; ll < DEPTH; ++ll) { KArgs ap = kargs(); unsigned char* ws = ap->ws;
                    LTID; pg8::GemmK1024 g{WSP(bf16, WS_MEMN) + (size_t)ll * 512 * DM, (const bf16*)(ws + WS_W + (size_t)ll * W_LAYER + W_CKV)};
                    pg8::StaticOrder S; S.init(2, 8, G, (bx + G - 128 - 16 * ll) % G); pg8::EpiF32 E{WSP(float, WS_KVRAW) + (size_t)ll * 512 * 2048, 2048};
                    pg8::gemm_phase<pg8::GemmK1024, pg8::EpiF32, pg8::StaticOrder, true, true, false>(lds + RING_OFF, g, S, E, tid); }
            }
            { KArgs ap = kargs(); unsigned char* ws = ap->ws; LTID; pg8::GemmK1024 g{WSP(bf16, WS_XB), (const bf16*)(ws + WS_W + (size_t)l * W_LAYER + W_IN)}; pg8::StaticOrder S; S.init(MROWS / 256, NPROJ / 256, G, bx);
              pg8::EpiScaled E{WSP(bf16, WS_PROJ), NPROJ, WSP(float, WS_SSQ), nullptr};
              pg8::gemm_phase<pg8::GemmK1024, pg8::EpiScaled, pg8::StaticOrder, true, true, false>(lds + RING_OFF, g, S, E, tid); }
            { KArgs ap = kargs(); unsigned char* ws = ap->ws; WAVE_IDS; const float* xin = (l == 0) ? ap->in[0] : (const float*)ap->out;
              gates_phase(xin, ap->in[3] + (size_t)l * 1024 * D_IN, ap->in[2] + l * 1024, WSP(float, WS_GATES), lds, vcu, G, wave, lane, tid); }
        }
        SEAM(P + 0);
        if (PHON(1) && IN(P + 1)) {
            { KArgs ap = kargs(); unsigned char* ws = ap->ws; WAVE_IDS;
              for (int t = gw; t < MROWS; t += NGW) qk_post_token(t, WSP(bf16, WS_PROJ), WSP(bf16, WS_DQP), WSP(const float2, WS_ROPE), ap->in[9] + l * 32, ap->in[10] + l * 32, ap->in[13] + l * 64, ap->in[14] + l * 64, lane);
              if (l == 0) for (int idx = gw; idx < DEPTH * 512; idx += NGW) mem_post_row(idx, WSP(float, WS_KVRAW), ap->in[20], ap->in[21], WSP(bf16, WS_KM), WSP(bf16, WS_VMT), lane); }
            { KArgs ap = kargs(); unsigned char* ws = ap->ws; float* GG = WSP(float, WS_MLSC); LTID;
              for (int it = vcu; it < 1024; it += G) ml_local_item(lds + RING_OFF, it, WSP(bf16, WS_PROJ), WSP(float, WS_GATES), ap->in[4] + l * 8, ap->in[5] + l * 8, WSP(float, WS_XB), WSP(float, WS_NLOC), GG, GG + 2048, tid); }
            { KArgs ap = kargs(); unsigned char* ws = ap->ws; LTID;
              for (int it = vcu; it < 1024; it += G) pool_item(lds + RING_OFF, it, WSP(bf16, WS_PROJ), ap->in[7] + (size_t)l * 16384, ap->in[8] + l * 256, WSP(bf16, WS_YCAT), tid); }
        }
        SEAM(P + 1);
        if (PHON(2) && IN(P + 2)) { KArgs ap = kargs(); unsigned char* ws = ap->ws; WAVE_IDS; float* GG = WSP(float, WS_MLSC); ml_scan(WSP(float, WS_XB), WSP(float, WS_NLOC), GG, GG + 2048, GG + 4096, gw, NGW, lane); }
        SEAM(P + 2);
        if (PHON(3) && IN(P + 3)) {
            const int upc = (768 + G - 1) / G;
#pragma unroll 1
            for (int i = 0; i < upc; ++i) { const int U = vcu * upc + i; if (U >= 768) break;
                KArgs ap = kargs(); unsigned char* ws = ap->ws; LTID; bf16* PROJ = WSP(bf16, WS_PROJ); bf16* DQP = WSP(bf16, WS_DQP); bf16* YCAT = WSP(bf16, WS_YCAT);
                const int bh = U >> 5, qb = U & 31, b = bh / 12, qh = bh % 12; const size_t r0 = (size_t)b * SEQ, rq = r0 + (size_t)qb * 256;
                const bf16 *Qp, *Kp, *Vp; bf16* Op; int pq, po;
                if (qh < 4) { Qp = PROJ + rq * NPROJ + P_GQ + qh * 64; pq = NPROJ; Kp = PROJ + r0 * NPROJ + P_GK + (qh >> 1) * 64; Vp = PROJ + r0 * NPROJ + P_GV + (qh >> 1) * 64; Op = YCAT + rq * DM + 768 + qh * 64; po = DM; }
                else { const int p = qh - 4, hh = p >> 1; Qp = DQP + rq * 512 + p * 64; pq = 512; Kp = PROJ + r0 * NPROJ + P_DK + hh * 64; Vp = PROJ + r0 * NPROJ + P_DV + hh * 64; Op = DQP + rq * 512 + p * 64; po = 512; }
                attn_body::attn_unit<8>((const attn_body::bf16*)Qp, pq, (const attn_body::bf16*)Kp, (const attn_body::bf16*)Vp, (attn_body::bf16*)Op, po, (char*)lds_raw + RING_OFF, tid);
            }
        }
        SEAM(P + 3);
        if (PHON(4) && IN(P + 4)) {
            { KArgs ap = kargs(); unsigned char* ws = ap->ws; float* GG = WSP(float, WS_MLSC); LTID;
              for (int it = vcu; it < 1024; it += G) ml_out_item(lds + RING_OFF, it, WSP(bf16, WS_PROJ), WSP(float, WS_GATES), ap->in[4] + l * 8, ap->in[5] + l * 8, WSP(float, WS_XB), WSP(float, WS_NLOC), GG + 4096, ap->in[6] + l * 256, WSP(bf16, WS_YCAT), tid); }
            { KArgs ap = kargs(); unsigned char* ws = ap->ws; WAVE_IDS;
              diff_combine(WSP(bf16, WS_DQP), ap->in[11] + l * 128, ap->in[12] + l * 64, 0.8f - 0.6f * expf(-0.3f * (float)l), WSP(bf16, WS_YCAT), gw, NGW, lane); }
        }
        SEAM(P + 4);
        if (PHON(5) && IN(P + 5)) { KArgs ap = kargs(); unsigned char* ws = ap->ws; const float* xin = (l == 0) ? ap->in[0] : (const float*)ap->out;
            LTID; pg8::GemmK1024 g{WSP(bf16, WS_YCAT), (const bf16*)(ws + WS_W + (size_t)l * W_LAYER + W_OUT)}; pg8::StaticOrder S; S.init(MROWS / 256, 4, G, bx);
            pg8::EpiRes E{xin, ap->out, WSP(bf16, WS_XB), WSP(float, WS_SSQ)}; pg8::gemm_phase<pg8::GemmK1024, pg8::EpiRes, pg8::StaticOrder, true, true, false>(lds + RING_OFF, g, S, E, tid); }
        SEAM(P + 5);
        if (PHON(6) && IN(P + 6)) { KArgs ap = kargs(); unsigned char* ws = ap->ws; LTID; pg8::GemmK1024 g{WSP(bf16, WS_XB), (const bf16*)(ws + WS_W + (size_t)l * W_LAYER + W_CQ)}; pg8::StaticOrder S; S.init(MROWS / 256, 4, G, bx);
            pg8::EpiScaled E{WSP(bf16, WS_CQ), DM, WSP(float, WS_SSQ), WSP(float, WS_HSSQ)}; pg8::gemm_phase<pg8::GemmK1024, pg8::EpiScaled, pg8::StaticOrder, true, true, false>(lds + RING_OFF, g, S, E, tid); }
        SEAM(P + 6);
        if (PHON(7) && IN(P + 7)) { KArgs ap = kargs(); unsigned char* ws = ap->ws; LTID; pg8::GemmHeads g{WSP(bf16, WS_CQ), WSP(bf16, WS_KM) + (size_t)l * 8 * 65536};
            pg8::StaticOrder S; S.init(MROWS / 256, 4, G, bx); pg8::EpiScore E{WSP(bf16, WS_PT), WSP(float, WS_HSSQ), WSP(float, WS_PSUM)};
            pg8::gemm_phase<pg8::GemmHeads, pg8::EpiScore, pg8::StaticOrder, true, true, false>(lds + RING_OFF, g, S, E, tid); }
        SEAM(P + 7);
        if (PHON(8) && IN(P + 8)) { KArgs ap = kargs(); unsigned char* ws = ap->ws; LTID; pg8::GemmHeads g{WSP(bf16, WS_PT), WSP(bf16, WS_VMT) + (size_t)l * 8 * 65536};
            pg8::StaticOrder S; S.init(MROWS / 256, 4, G, bx); pg8::EpiPV E{WSP(bf16, WS_CO), WSP(float, WS_PSUM)};
            pg8::gemm_phase<pg8::GemmHeads, pg8::EpiPV, pg8::StaticOrder, true, true, false>(lds + RING_OFF, g, S, E, tid); }
        SEAM(P + 8);
        if (PHON(9) && IN(P + 9)) { KArgs ap = kargs(); unsigned char* ws = ap->ws; LTID; pg8::GemmK1024 g{WSP(bf16, WS_CO), (const bf16*)(ws + WS_W + (size_t)l * W_LAYER + W_CO)}; pg8::StaticOrder S; S.init(MROWS / 256, 4, G, bx);
            pg8::EpiRes E{ap->out, ap->out, WSP(bf16, WS_XB), WSP(float, WS_SSQ)}; pg8::gemm_phase<pg8::GemmK1024, pg8::EpiRes, pg8::StaticOrder, true, true, false>(lds + RING_OFF, g, S, E, tid); }
        SEAM(P + 9);
        if (PHON(10) && IN(P + 10)) { KArgs ap = kargs(); unsigned char* ws = ap->ws; LTID; pg8::GemmConv g{WSP(bf16, WS_XB) - DM, (const bf16*)(ws + WS_W + (size_t)l * W_LAYER + W_FI)};
            pg8::StaticOrder S; S.init(67, NFF / 256, G, bx); pg8::EpiFFN E{WSP(bf16, WS_ACT), WSP(float, WS_SSQ), ap->in[25] + (size_t)l * 3 * DFF, ap->in[26] + (size_t)l * DFF, MROWS};
            pg8::gemm_phase<pg8::GemmConv, pg8::EpiFFN, pg8::StaticOrder, true, true, true>(lds + RING_OFF, g, S, E, tid); }
        SEAM(P + 10);
        if (PHON(11) && IN(P + 11)) { KArgs ap = kargs(); unsigned char* ws = ap->ws; LTID; pg8::GemmK2816 g{WSP(bf16, WS_ACT), (const bf16*)(ws + WS_W + (size_t)l * W_LAYER + W_FO)}; pg8::StaticOrder S; S.init(MROWS / 256, 4, G, bx);
            pg8::EpiRes E{ap->out, ap->out, WSP(bf16, WS_XB), WSP(float, WS_SSQ)}; pg8::gemm_phase<pg8::GemmK2816, pg8::EpiRes, pg8::StaticOrder, true, true, false>(lds + RING_OFF, g, S, E, tid); }
        SEAM(P + 11);
    }
#undef IN
#undef SEAM
}

#ifndef MK_CUTS
#define MK_CUTS 0
#endif
extern "C" void kernel_launch(void* const* d_in, const int* in_sizes, int n_in, void* d_out, int out_size, void* d_ws, size_t ws_size, hipStream_t stream) {
    static int grid = 0;
    if (grid == 0) {
        if (n_in != 28 || out_size != MROWS * DM || ws_size < WS_END) { fprintf(stderr, "kernel_launch: unexpected shapes (n_in %d, out %d, ws %zu)\n", n_in, out_size, ws_size); grid = -1; return; }
        int dev = 0, cus = 0, per_cu = 0;
        hipGetDevice(&dev); hipDeviceGetAttribute(&cus, hipDeviceAttributeMultiprocessorCount, dev);
        if (hipFuncSetAttribute((const void*)hybrid_fwd, hipFuncAttributeMaxDynamicSharedMemorySize, LDS_BYTES) != hipSuccess) { fprintf(stderr, "kernel_launch: hipFuncSetAttribute failed\n"); grid = -1; return; }
        if (hipOccupancyMaxActiveBlocksPerMultiprocessor(&per_cu, (const void*)hybrid_fwd, NTHR, LDS_BYTES) != hipSuccess || per_cu < 1) { fprintf(stderr, "kernel_launch: occupancy query says %d\n", per_cu); per_cu = 1; }
        (void)hipGetLastError();
        grid = cus;
    }
    if (grid < 0) return;
    hipMemsetAsync((char*)d_ws + WS_CTL, 0, CTL_ZERO_BYTES, stream);
    Args a{};
    for (int i = 0; i < 28; ++i) a.in[i] = (const float*)d_in[i];
    a.out = (float*)d_out; a.ws = (unsigned char*)d_ws;
    constexpr int NPH = 1 + 12 * DEPTH;
#if MK_CUTS
    for (int p = 0; p < NPH; ++p) { a.ph_lo = p; a.ph_hi = p + 1; void* kargs[] = {&a};
        hipError_t e = hipLaunchCooperativeKernel((const void*)hybrid_fwd, dim3(grid), dim3(NTHR), kargs, LDS_BYTES, stream);
        if (e != hipSuccess) { fprintf(stderr, "launch %d failed: %s\n", p, hipGetErrorString(e)); break; } }
#else
    a.ph_lo = 0; a.ph_hi = NPH; void* kargs[] = {&a};
    hipError_t e = hipLaunchCooperativeKernel((const void*)hybrid_fwd, dim3(grid), dim3(NTHR), kargs, LDS_BYTES, stream);
    if (e != hipSuccess) fprintf(stderr, "cooperative launch failed: %s (grid %d)\n", hipGetErrorString(e), grid);
#endif
}
```

```cpp
#include <hip/hip_runtime.h>
#include <hip/hip_cooperative_groups.h>
#include <hip/hip_bf16.h>
#include <cstdio>
#include <cstdint>
#include <cmath>
namespace cg = cooperative_groups;
__device__ __forceinline__ float bperm(int srclane, float v) { return __int_as_float(__builtin_amdgcn_ds_bpermute(srclane << 2, __float_as_int(v))); }
#define SHX(v, m) bperm(lane ^ (m), (v))
#define SHU(v, o) bperm(lane - (o), (v))
#define SHD(v, o) bperm(lane + (o), (v))
#define SHI(v, src) bperm((src), (v))

namespace pg8 {
#define PG8_LAS __attribute__((address_space(3)))
typedef unsigned short bf16_t;
typedef short bf16x8 __attribute__((ext_vector_type(8)));
typedef float f32x4 __attribute__((ext_vector_type(4)));
typedef unsigned u32x4 __attribute__((ext_vector_type(4)));
typedef unsigned u32x2 __attribute__((ext_vector_type(2)));
constexpr int BM = 256, BK = 64, HALF = 128, HTB = HALF * BK * 2  , STAGE_BYTES = 8 * HTB, NXCD = 8, WGM = 8;

__host__ __device__ __forceinline__ int lds_byte(int r, int c) { const int st = (r >> 4) * 2 + (c >> 5), rr = r & 15, cc = c & 31, ob = rr * 64 + cc * 2; return st * 1024 + (ob ^ (((ob >> 9) & 1) << 5)); }
__host__ __device__ __forceinline__ void stage_rc(int b, int& R, int& C) { const int st = b / 1024, sb = b % 1024, swz = sb ^ (((sb >> 9) & 1) << 5); R = (st >> 1) * 16 + swz / 64; C = (st & 1) * 32 + (swz % 64) / 2; }
__host__ __device__ __forceinline__ int perm32(int rho) { const int n = rho >> 4, i = rho & 15; return 8 * (i >> 2) + 4 * n + (i & 3); }

struct Unit { int pm, pn; };
template <int LDA, int LDB, int KK, long AT, long AN, long BN, long BZ, int ZDIV> struct GemmT {
    const bf16_t* A; const bf16_t* Bt;
    static constexpr int lda = LDA, ldb = LDB, K = KK;
    __device__ __forceinline__ long offA(const Unit& u) const { return (long)u.pm * AT + (long)u.pn * AN; }
    __device__ __forceinline__ long offB(const Unit& u) const { return (long)u.pn * BN + (ZDIV > 0 ? (long)(u.pm / (ZDIV > 0 ? ZDIV : 1)) * BZ : 0L); }
};
typedef GemmT<1024, 1024, 1024, 256L * 1024 * 2, 0, 256L * 1024 * 2, 0, 0> GemmK1024;
typedef GemmT<2816, 2816, 2816, 256L * 2816 * 2, 0, 256L * 2816 * 2, 0, 0> GemmK2816;
typedef GemmT<1024, 1024, 1024, 248L * 1024 * 2, 0, 256L * 1024 * 2, 0, 0> GemmConv;
typedef GemmT<1024, 256, 256, 256L * 1024 * 2, 512, 65536L * 2, 4L * 65536 * 2, 32> GemmHeads;

struct StaticOrder {
    int nM, nN, nwg, G, c, pn0;
    __host__ __device__ void init(int nM_, int nN_, int G_, int c_, int pn0_ = 0) { nM = nM_; nN = nN_; nwg = nM * nN; G = G_; c = c_; pn0 = pn0_; }
    __host__ __device__ bool next(int i, Unit& u) const {
        const long L = (long)i * G + c; if (L >= nwg) return false;
        int wgid = (int)L; { const int q = nwg / NXCD, r = nwg % NXCD, xcd = wgid % NXCD, off = wgid / NXCD; wgid = (xcd < r ? xcd * (q + 1) : r * (q + 1) + (xcd - r) * q) + off; }
        const int nig = WGM * nN, gid = wgid / nig, fm = gid * WGM, gsz = (nM - fm) < WGM ? (nM - fm) : WGM;
        u.pm = fm + ((wgid % nig) % gsz); u.pn = pn0 + (wgid % nig) / gsz; return true;
    }
    __device__ __forceinline__ void a_ready(const Unit&) const {}
    __device__ __forceinline__ void done(const Unit&) const {}
};
__device__ __forceinline__ unsigned cvt_pk_bf16(float lo, float hi) { unsigned r; asm volatile("v_cvt_pk_bf16_f32 %0, %1, %2" : "=v"(r) : "v"(lo), "v"(hi)); return r; }


template <class GT, class Epi, class Sched, bool ALIGN_EPI = false, bool SP2 = false, bool CONV = false>
__device__ __forceinline__ void gemm_phase(PG8_LAS unsigned char* lds, const GT g, const Sched& S, const Epi& E, const int tid_in) {
    static_assert(SP2, "only the SP2 loop is kept valid here");
    int tid_l = tid_in; asm volatile("" : "+v"(tid_l));
    const int tid = tid_l, wid = __builtin_amdgcn_readfirstlane(tid >> 6), lane = tid & 63, wr = wid >> 2, wc = wid & 3, fr = lane & 15, fq = lane >> 4;
    constexpr int nt = GT::K / BK;
    unsigned voffA[2], voffB[2];
#pragma unroll
    for (int i = 0; i < 2; ++i) { int R, C; stage_rc(tid * 16 + i * 8192, R, C); const int Rb = Epi::PERM ? ((R & ~31) + perm32(R & 31)) : R;
        const int Ra = CONV ? (R - 2 * (R >> 6)) : R; voffA[i] = (unsigned)(Ra * GT::lda + C) * 2u; voffB[i] = (unsigned)(Rb * GT::ldb + C) * 2u; }
    const size_t kstep = (size_t)(BK * 2);
    constexpr size_t hA = (size_t)(CONV ? 124 : HALF) * GT::lda * 2, hB = (size_t)HALF * GT::ldb * 2;
    const unsigned ldsw = (unsigned)wid * 1024u;
    const int aoff = lds_byte(wr * 64 + fr, fq * 8), boff = lds_byte(wc * 32 + fr, fq * 8);
#define PG8_SA(b, h) (((b) * 2 + (h)) * HTB)
#define PG8_SB(b, h) ((4 + (b) * 2 + (h)) * HTB)
#define PG8_STAGE(bufoff, gbase, voff) do { _Pragma("unroll") for (int _i = 0; _i < 2; ++_i) \
        __builtin_amdgcn_global_load_lds((const unsigned*)((const char*)(gbase) + (voff)[_i]), (PG8_LAS unsigned*)(lds + (bufoff) + ldsw + _i * 8192), 16, 0, 0); } while (0)
#define PG8_LDA(dst, b, h) do { _Pragma("unroll") for (int m = 0; m < 4; ++m) _Pragma("unroll") for (int k = 0; k < 2; ++k) dst[m][k] = *(const PG8_LAS bf16x8*)(lds + PG8_SA(b, h) + aoff + m * 2048 + k * 1024); } while (0)
#define PG8_LDB(dst, b, h) do { _Pragma("unroll") for (int n = 0; n < 2; ++n) _Pragma("unroll") for (int k = 0; k < 2; ++k) dst[n][k] = *(const PG8_LAS bf16x8*)(lds + PG8_SB(b, h) + boff + n * 2048 + k * 1024); } while (0)
#define PG8_MMA(ai, bj, At, Bt) do { __builtin_amdgcn_s_setprio(1); _Pragma("unroll") for (int m = 0; m < 4; ++m) _Pragma("unroll") for (int n = 0; n < 2; ++n) _Pragma("unroll") for (int k = 0; k < 2; ++k) \
        acc[ai][bj][m][n] = __builtin_amdgcn_mfma_f32_16x16x32_bf16(Bt[n][k], At[m][k], acc[ai][bj][m][n], 0, 0, 0); __builtin_amdgcn_s_setprio(0); } while (0)
#define PG8_WAIT_V(n) asm volatile("s_waitcnt vmcnt(" #n ")" ::: "memory")
#define PG8_WAIT_L(n) asm volatile("s_waitcnt lgkmcnt(" #n ")" ::: "memory")
#define PG8_BAR __builtin_amdgcn_s_barrier()
#define PG8_SCHED __builtin_amdgcn_sched_barrier(0)
    Unit cur, nxt; int ui = 0;
    if (!S.next(0, cur)) return;
    f32x4 acc[2][2][4][2];
#pragma unroll
    for (int a = 0; a < 2; ++a)
#pragma unroll
        for (int b = 0; b < 2; ++b)
#pragma unroll
            for (int m = 0; m < 4; ++m)
#pragma unroll
                for (int n = 0; n < 2; ++n) acc[a][b][m][n] = (f32x4){0.f, 0.f, 0.f, 0.f};
    bf16x8 At[4][2], B0[2][2], B1[2][2];
    const char* cA = (const char*)g.A + g.offA(cur); const char* cB = (const char*)g.Bt + g.offB(cur);
    S.a_ready(cur);
    if constexpr (SP2) {
        PG8_STAGE(PG8_SB(0, 0), cB, voffB); PG8_STAGE(PG8_SB(0, 1), cB + hB, voffB); PG8_STAGE(PG8_SA(0, 0), cA, voffA); PG8_STAGE(PG8_SA(0, 1), cA + hA, voffA);
        if (wr == 1) PG8_BAR;
        PG8_WAIT_V(2); PG8_BAR;
        PG8_STAGE(PG8_SB(1, 0), cB + kstep, voffB); PG8_STAGE(PG8_SA(1, 0), cA + kstep, voffA); PG8_STAGE(PG8_SB(1, 1), cB + hB + kstep, voffB);
        PG8_WAIT_V(6); PG8_BAR;
    } else {
        PG8_STAGE(PG8_SB(0, 0), cB, voffB); PG8_STAGE(PG8_SA(0, 0), cA, voffA); PG8_STAGE(PG8_SB(0, 1), cB + hB, voffB); PG8_STAGE(PG8_SA(0, 1), cA + hA, voffA);
        if (wr == 1) PG8_BAR;
        PG8_WAIT_V(4); PG8_BAR;
        PG8_STAGE(PG8_SB(1, 0), cB + kstep, voffB); PG8_STAGE(PG8_SA(1, 0), cA + kstep, voffA); PG8_STAGE(PG8_SB(1, 1), cB + hB + kstep, voffB);
        PG8_WAIT_V(6); PG8_BAR;
    }
    for (;;) {
        const bool has_next = S.next(ui + 1, nxt);
        const char* nA = has_next ? (const char*)g.A + g.offA(nxt) : cA; const char* nB = has_next ? (const char*)g.Bt + g.offB(nxt) : cB;
        for (int t = 0; t < nt; t += 2) {
            const bool last = (t == nt - 2);
            const char* a1 = cA + (size_t)(t + 1) * kstep;
            const char* a2 = last ? nA : cA + (size_t)(t + 2) * kstep; const char* b2 = last ? nB : cB + (size_t)(t + 2) * kstep;
            const char* a3 = a2 + kstep; const char* b3 = b2 + kstep;
            if (last && has_next) S.a_ready(nxt);
            if constexpr (SP2) {
            PG8_LDB(B0, 0, 0); PG8_LDB(B1, 0, 1); PG8_SCHED; PG8_LDA(At, 0, 0); PG8_STAGE(PG8_SA(1, 1), a1 + hA, voffA);
            PG8_WAIT_V(8); PG8_WAIT_L(0); PG8_BAR; PG8_MMA(0, 0, At, B0); PG8_MMA(0, 1, At, B1); PG8_BAR; PG8_SCHED;
            PG8_LDA(At, 0, 1); PG8_STAGE(PG8_SB(0, 0), b2, voffB); PG8_STAGE(PG8_SB(0, 1), b2 + hB, voffB); PG8_STAGE(PG8_SA(0, 0), a2, voffA);
            PG8_WAIT_V(8); PG8_WAIT_L(0); PG8_BAR; PG8_MMA(1, 0, At, B0); PG8_MMA(1, 1, At, B1); PG8_BAR; PG8_SCHED;
            PG8_LDB(B0, 1, 0); PG8_LDB(B1, 1, 1); PG8_SCHED; PG8_LDA(At, 1, 0); PG8_STAGE(PG8_SA(0, 1), a2 + hA, voffA);
            PG8_WAIT_V(8); PG8_WAIT_L(0); PG8_BAR; PG8_MMA(0, 0, At, B0); PG8_MMA(0, 1, At, B1); PG8_BAR; PG8_SCHED;
            PG8_LDA(At, 1, 1); PG8_STAGE(PG8_SB(1, 0), b3, voffB); PG8_STAGE(PG8_SB(1, 1), b3 + hB, voffB); PG8_STAGE(PG8_SA(1, 0), a3, voffA);
            PG8_WAIT_V(8); PG8_WAIT_L(0); PG8_BAR; PG8_MMA(1, 0, At, B0); PG8_MMA(1, 1, At, B1); PG8_BAR; PG8_SCHED;
            } else {
            PG8_LDB(B0, 0, 0); PG8_SCHED; PG8_LDA(At, 0, 0); PG8_STAGE(PG8_SA(1, 1), a1 + hA, voffA);
            PG8_WAIT_L(8); PG8_BAR; PG8_WAIT_L(0); PG8_MMA(0, 0, At, B0); PG8_BAR; PG8_SCHED;
            PG8_LDB(B1, 0, 1); PG8_STAGE(PG8_SB(0, 0), b2, voffB);
            PG8_BAR; PG8_WAIT_L(0); PG8_MMA(0, 1, At, B1); PG8_BAR;
            PG8_LDA(At, 0, 1); PG8_STAGE(PG8_SA(0, 0), a2, voffA);
            PG8_BAR; PG8_WAIT_L(0); PG8_MMA(1, 0, At, B0); PG8_BAR; PG8_SCHED;
            PG8_STAGE(PG8_SB(0, 1), b2 + hB, voffB);
            PG8_WAIT_V(6); PG8_BAR; PG8_MMA(1, 1, At, B1); PG8_BAR;
            PG8_LDB(B0, 1, 0); PG8_SCHED; PG8_LDA(At, 1, 0); PG8_STAGE(PG8_SA(0, 1), a2 + hA, voffA);
            PG8_WAIT_L(8); PG8_BAR; PG8_WAIT_L(0); PG8_MMA(0, 0, At, B0); PG8_BAR; PG8_SCHED;
            PG8_LDB(B1, 1, 1); PG8_STAGE(PG8_SB(1, 0), b3, voffB);
            PG8_BAR; PG8_WAIT_L(0); PG8_MMA(0, 1, At, B1); PG8_BAR;
            PG8_LDA(At, 1, 1); PG8_STAGE(PG8_SA(1, 0), a3, voffA);
            PG8_BAR; PG8_WAIT_L(0); PG8_MMA(1, 0, At, B0); PG8_BAR; PG8_SCHED;
            PG8_STAGE(PG8_SB(1, 1), b3 + hB, voffB);
            PG8_WAIT_V(6); PG8_BAR; PG8_MMA(1, 1, At, B1); PG8_BAR;
            }
        }
        if constexpr (ALIGN_EPI) { if (wr == 0) PG8_BAR; }
        if constexpr (!Epi::AFTER_DRAIN) { { int l_e; asm volatile("v_mbcnt_lo_u32_b32 %0, -1, 0\n\tv_mbcnt_hi_u32_b32 %0, -1, %0" : "=v"(l_e)); E(acc, cur, wr, wc, l_e & 15, l_e >> 4); } S.done(cur); }
        if (!has_next) break;
#pragma unroll
        for (int a = 0; a < 2; ++a)
#pragma unroll
            for (int b = 0; b < 2; ++b)
#pragma unroll
                for (int m = 0; m < 4; ++m)
#pragma unroll
                    for (int n = 0; n < 2; ++n) acc[a][b][m][n] = (f32x4){0.f, 0.f, 0.f, 0.f};
        cur = nxt; cA = nA; cB = nB; ++ui;
        if constexpr (ALIGN_EPI) { if (wr == 1) PG8_BAR; }
    }
    PG8_WAIT_V(0);
    if constexpr (!ALIGN_EPI) { if (wr == 0) PG8_BAR; }
    PG8_BAR;
    if constexpr (Epi::AFTER_DRAIN) { E.fused(acc, cur, wr, wc, fr, fq, lds, wid, lane); S.done(cur); }
#undef PG8_SA
#undef PG8_SB
#undef PG8_STAGE
#undef PG8_LDA
#undef PG8_LDB
#undef PG8_MMA
#undef PG8_WAIT_V
#undef PG8_WAIT_L
#undef PG8_BAR
#undef PG8_SCHED
}

template <int CTRL> __device__ __forceinline__ float dpp_ror(float v) { return __int_as_float(__builtin_amdgcn_update_dpp(0, __float_as_int(v), CTRL, 0xf, 0xf, false)); }
template <int CTRL> __device__ __forceinline__ float dpp_shift(float old, float v) { return __int_as_float(__builtin_amdgcn_update_dpp(__float_as_int(old), __float_as_int(v), CTRL, 0xf, 0xf, false)); }
typedef f32x4 Acc[2][2][4][2];
__device__ __forceinline__ float sum16(const float* p) {
    const f32x4 a = *(const f32x4*)p, b = *(const f32x4*)(p + 4), c = *(const f32x4*)(p + 8), d = *(const f32x4*)(p + 12);
    return ((a[0] + a[1]) + (a[2] + a[3])) + ((b[0] + b[1]) + (b[2] + b[3])) + ((c[0] + c[1]) + (c[2] + c[3])) + ((d[0] + d[1]) + (d[2] + d[3]));
}
__device__ __forceinline__ float sum16q(const float* p, int fq, int lane) {
    const f32x4 a = *(const f32x4*)(p + 4 * fq); float s = (a[0] + a[1]) + (a[2] + a[3]); s += SHX(s, 16); s += SHX(s, 32); return s;
}
__device__ __forceinline__ float dot4(const f32x4 v) { return (v[0] * v[0] + v[1] * v[1]) + (v[2] * v[2] + v[3] * v[3]); }
__device__ __forceinline__ u32x4 pack8(const f32x4 a, const f32x4 b) { u32x4 w; w.x = cvt_pk_bf16(a[0], a[1]); w.y = cvt_pk_bf16(a[2], a[3]); w.z = cvt_pk_bf16(b[0], b[1]); w.w = cvt_pk_bf16(b[2], b[3]); return w; }

struct EpiScaled {
    static constexpr bool PERM = true, AFTER_DRAIN = false;
    bf16_t* O; int ldc; const float* ssq; float* HS;
    __device__ __forceinline__ void operator()(Acc& acc, const Unit& u, int wr, int wc, int fr, int fq) const {
        const int lane = fq * 16 + fr; (void)lane; const int row0 = u.pm * BM + wr * 64 + fr, col0 = u.pn * BM + wc * 32 + 8 * fq;
        float rsv[2][4];
#pragma unroll
        for (int ai = 0; ai < 2; ++ai)
#pragma unroll
            for (int m = 0; m < 4; ++m) rsv[ai][m] = __builtin_amdgcn_rsqf(sum16q(ssq + (size_t)(row0 + ai * HALF + m * 16) * 16, fq, lane) * (1.0f / 1024.0f) + 1e-6f);
#pragma unroll
        for (int ai = 0; ai < 2; ++ai)
#pragma unroll
            for (int m = 0; m < 4; ++m) { const int r = row0 + ai * HALF + m * 16; const float rs = rsv[ai][m];
                bf16_t* rowp = O + (size_t)r * ldc + col0; float ss = 0.f;
#pragma unroll
                for (int bj = 0; bj < 2; ++bj) { const f32x4 v0 = acc[ai][bj][m][0] * rs, v1 = acc[ai][bj][m][1] * rs; ss += dot4(v0) + dot4(v1); *(u32x4*)(rowp + bj * HALF) = pack8(v0, v1); }
                if (HS) { ss += SHX(ss, 16); ss += SHX(ss, 32); if (fq == 0) HS[(size_t)r * 16 + u.pn * 4 + wc] = ss; } }
    }
};
struct EpiRes {
    static constexpr bool PERM = false, AFTER_DRAIN = false;
    const float* base32; float* out32; bf16_t* xb; float* ssq;
    __device__ __forceinline__ void operator()(Acc& acc, const Unit& u, int wr, int wc, int fr, int fq) const {
        const int lane = fq * 16 + fr; (void)lane; const int row0 = u.pm * BM + wr * 64 + fr, col0 = u.pn * BM + wc * 32 + 4 * fq;
#pragma unroll
        for (int ai = 0; ai < 2; ++ai)
#pragma unroll
            for (int m = 0; m < 4; ++m) { if ((m & 1) == 0) asm volatile("" ::: "memory"); const int r = row0 + ai * HALF + m * 16; const size_t off = (size_t)r * 1024 + col0; float ss = 0.f;
#pragma unroll
                for (int bj = 0; bj < 2; ++bj)
#pragma unroll
                    for (int n = 0; n < 2; ++n) { const size_t o_ = off + bj * HALF + n * 16; f32x4 o;
                        if (base32) o = *(const f32x4*)(base32 + o_);
                        else { const u32x2 b = *(const u32x2*)(xb + o_); o = (f32x4){__uint_as_float(b.x << 16), __uint_as_float(b.x & 0xffff0000u), __uint_as_float(b.y << 16), __uint_as_float(b.y & 0xffff0000u)}; }
                        o = o + acc[ai][bj][m][n]; ss += dot4(o);
                        if (out32) *(f32x4*)(out32 + o_) = o;
                        u32x2 w; w.x = cvt_pk_bf16(o[0], o[1]); w.y = cvt_pk_bf16(o[2], o[3]); *(u32x2*)(xb + o_) = w; }
                ss += SHX(ss, 16); ss += SHX(ss, 32); if (fq == 0) ssq[(size_t)r * 16 + u.pn * 4 + wc] = ss; }
    }
};
struct EpiF32 {
    static constexpr bool PERM = false, AFTER_DRAIN = false;
    float* out; int ldc;
    __device__ __forceinline__ void operator()(Acc& acc, const Unit& u, int wr, int wc, int fr, int fq) const {
        const int lane = fq * 16 + fr; (void)lane; const int row0 = u.pm * BM + wr * 64 + fr, col0 = u.pn * BM + wc * 32 + 4 * fq;
#pragma unroll
        for (int ai = 0; ai < 2; ++ai)
#pragma unroll
            for (int m = 0; m < 4; ++m) { const size_t off = (size_t)(row0 + ai * HALF + m * 16) * ldc + col0;
#pragma unroll
                for (int bj = 0; bj < 2; ++bj)
#pragma unroll
                    for (int n = 0; n < 2; ++n) *(f32x4*)(out + off + bj * HALF + n * 16) = acc[ai][bj][m][n]; }
    }
};
struct EpiScore {
    static constexpr bool PERM = true, AFTER_DRAIN = false;
    bf16_t* PT; const float* HS; float* PS;
    __device__ __forceinline__ void operator()(Acc& acc, const Unit& u, int wr, int wc, int fr, int fq) const {
        const int lane = fq * 16 + fr; (void)lane; const int row0 = u.pm * BM + wr * 64 + fr, col0 = u.pn * BM + wc * 32 + 8 * fq;
#pragma unroll
        for (int ai = 0; ai < 2; ++ai)
#pragma unroll
            for (int m = 0; m < 4; ++m) { const int r = row0 + ai * HALF + m * 16; const f32x4 h4 = *(const f32x4*)(HS + (size_t)r * 16 + u.pn * 4);
                const float rq = __builtin_amdgcn_rsqf(((h4[0] + h4[1]) + (h4[2] + h4[3])) * (1.0f / 256.0f) + 1e-6f); bf16_t* rowp = PT + (size_t)r * 1024 + col0; float ss = 0.f;
#pragma unroll
                for (int bj = 0; bj < 2; ++bj) { f32x4 v0 = acc[ai][bj][m][0] * rq, v1 = acc[ai][bj][m][1] * rq;
#pragma unroll
                    for (int j = 0; j < 4; ++j) { v0[j] = __builtin_amdgcn_exp2f(v0[j]); v1[j] = __builtin_amdgcn_exp2f(v1[j]); }
                    ss += ((v0[0] + v0[1]) + (v0[2] + v0[3])) + ((v1[0] + v1[1]) + (v1[2] + v1[3])); *(u32x4*)(rowp + bj * HALF) = pack8(v0, v1); }
                ss += SHX(ss, 16); ss += SHX(ss, 32); if (fq == 0) PS[(size_t)r * 16 + u.pn * 4 + wc] = ss; }
    }
};
struct EpiPV {
    static constexpr bool PERM = true, AFTER_DRAIN = false;
    bf16_t* O; const float* PS;
    __device__ __forceinline__ void operator()(Acc& acc, const Unit& u, int wr, int wc, int fr, int fq) const {
        const int lane = fq * 16 + fr; (void)lane; const int row0 = u.pm * BM + wr * 64 + fr, col0 = u.pn * BM + wc * 32 + 8 * fq;
#pragma unroll
        for (int ai = 0; ai < 2; ++ai)
#pragma unroll
            for (int m = 0; m < 4; ++m) { const int r = row0 + ai * HALF + m * 16; const f32x4 p4 = *(const f32x4*)(PS + (size_t)r * 16 + u.pn * 4);
                const float inv = 1.0f / ((p4[0] + p4[1]) + (p4[2] + p4[3])); bf16_t* rowp = O + (size_t)r * 1024 + col0;
#pragma unroll
                for (int bj = 0; bj < 2; ++bj) *(u32x4*)(rowp + bj * HALF) = pack8(acc[ai][bj][m][0] * inv, acc[ai][bj][m][1] * inv); }
    }
};
struct EpiFFN {
    static constexpr bool PERM = true, AFTER_DRAIN = false;
    bf16_t* act; const float* ssq; const float* cw; const float* cb; int Mrows;
    __device__ __forceinline__ void operator()(Acc& acc, const Unit& u, int wr, int wc, int fr, int fq) const {
        const int lane = fq * 16 + fr; const int jc = u.pn * 128 + wc * 32 + 8 * fq;
        float rsv[2][4];
#pragma unroll
        for (int ai = 0; ai < 2; ++ai)
#pragma unroll
            for (int m = 0; m < 4; ++m) { const int gr = 62 * (4 * u.pm + 2 * ai + wr) - 1 + 16 * m + fr; const bool valid = gr >= 0 && gr < Mrows; const int grc = valid ? gr : 0;
                const float rs = __builtin_amdgcn_rsqf(sum16q(ssq + (size_t)grc * 16, fq, lane) * (1.0f / 1024.0f) + 1e-6f); rsv[ai][m] = valid ? rs : 0.f; }
#pragma unroll
        for (int ai = 0; ai < 2; ++ai)
#pragma unroll
            for (int m = 0; m < 4; ++m)
#pragma unroll
                for (int bj = 0; bj < 2; ++bj)
#pragma unroll
                    for (int n = 0; n < 2; ++n)
#pragma unroll
                        for (int j = 0; j < 4; ++j) { const float v = acc[ai][bj][m][n][j] * rsv[ai][m]; acc[ai][bj][m][n][j] = (rsv[ai][m] == 0.f) ? 0.f : v; }
#pragma unroll
        for (int n = 0; n < 2; ++n) {
            asm volatile("" ::: "memory");
            const f32x4 w0 = *(const f32x4*)(cw + jc + 4 * n), w1 = *(const f32x4*)(cw + 2816 + jc + 4 * n), w2 = *(const f32x4*)(cw + 5632 + jc + 4 * n), bb = *(const f32x4*)(cb + jc + 4 * n);
#pragma unroll
            for (int ai = 0; ai < 2; ++ai) {
                const int g0 = 62 * (4 * u.pm + 2 * ai + wr) - 1;
#pragma unroll
                for (int m = 0; m < 4; ++m) { const int rr = 16 * m + fr, gr = g0 + rr, t = gr & 8191; f32x4 o;
#pragma unroll
                    for (int j = 0; j < 4; ++j) { const float cur = acc[ai][0][m][n][j];
                        const float up_wrap = (m > 0) ? dpp_ror<0x121>(acc[ai][0][m > 0 ? m - 1 : 0][n][j]) : 0.f;
                        const float dn_wrap = (m < 3) ? dpp_ror<0x12F>(acc[ai][0][m < 3 ? m + 1 : 3][n][j]) : 0.f;
                        float prev = dpp_shift<0x111>(up_wrap, cur), next = dpp_shift<0x101>(dn_wrap, cur);
                        prev = (t == 0) ? 0.f : prev; next = (t == 8191) ? 0.f : next;
                        const float gc = w0[j] * prev + w1[j] * cur + w2[j] * next + bb[j];
                        o[j] = gc * __builtin_amdgcn_rcpf(1.0f + __expf(-gc)) * acc[ai][1][m][n][j]; }
                    if (rr >= 1 && rr <= 62 && gr < Mrows) { u32x2 w; w.x = cvt_pk_bf16(o[0], o[1]); w.y = cvt_pk_bf16(o[2], o[3]); *(u32x2*)(act + (size_t)gr * 2816 + jc + 4 * n) = w; }
                    __builtin_amdgcn_sched_barrier(0); }
            }
        }
    }
};
}

namespace attn_body {
using bf16=__hip_bfloat16;
using bf16x8=__attribute__((ext_vector_type(8)))short;
using s16x4=__attribute__((ext_vector_type(4)))short;
using f32x16=__attribute__((ext_vector_type(16)))float;
using u32x4=__attribute__((ext_vector_type(4)))unsigned;
constexpr int SEQ=8192,D=64,ldk=2560,ldv=2560;
constexpr int NW=8,QBLK=32,QB=QBLK*NW,KVBLK=64,NQB=SEQ/QB;
constexpr int ATTN_UNIT_ROWS=QB;
__device__ __forceinline__ int crow(int r,int hi){return (r&3)+8*(r>>2)+4*hi;}
#define SBAR() __builtin_amdgcn_sched_barrier(0)
__device__ __forceinline__ void cmask(f32x16&p0,f32x16&p1,int jb,int qrel,int hi){
  const float NEG=-INFINITY; int kb=64*jb+4*hi;
  #pragma unroll
  for(int r=0;r<16;++r){int kv=kb+(r&3)+8*(r>>2); if(kv>qrel)p0[r]=NEG; if(kv+32>qrel)p1[r]=NEG;}
}

constexpr int NSLOT=3, SLOTB=8192;
constexpr int LDS_K=0, LDS_V=NSLOT*SLOTB, LDS_WS=2*NSLOT*SLOTB, LDS_OST=LDS_WS+NW*64*4, LDS_BYTES=LDS_OST+NW*4096;
constexpr float C2=0.125f*1.4426950408889634f;
__device__ __forceinline__ void glds16(const void*gsrc,unsigned lds_dst){unsigned keep;
  asm volatile("s_mov_b32 %0, m0\n\ts_mov_b32 m0, %2\n\ts_nop 0\n\tglobal_load_lds_dwordx4 %1, off\n\ts_mov_b32 m0, %0":"=&s"(keep):"v"(gsrc),"s"(lds_dst):"memory");}
__device__ __forceinline__ float max3f(float a,float b,float c){float r;asm("v_max3_f32 %0, %1, %2, %3":"=v"(r):"v"(a),"v"(b),"v"(c));return r;}
__device__ __forceinline__ float max2f(float a,float b){float r;asm("v_max_f32_e32 %0, %1, %2":"=v"(r):"v"(a),"v"(b));return r;}
__device__ __forceinline__ float fadd_s(float a,float b){float r;asm("v_add_f32_e32 %0, %1, %2":"=v"(r):"v"(a),"v"(b));return r;}
__device__ __forceinline__ float fsub_s(float a,float b){float r;asm("v_sub_f32_e32 %0, %1, %2":"=v"(r):"v"(a),"v"(b));return r;}
typedef float f32x2_t __attribute__((ext_vector_type(2))); typedef __bf16 bf16x2_t __attribute__((ext_vector_type(2)));
__device__ __forceinline__ unsigned cvtpk_s(float lo,float hi){f32x2_t v={lo,hi};bf16x2_t b=__builtin_convertvector(v,bf16x2_t);return __builtin_bit_cast(unsigned,b);}
#define WAIT_BAR(N) asm volatile("s_waitcnt vmcnt(" #N ") lgkmcnt(0)\n\ts_barrier":::"memory")

template<int MODE> __device__ __forceinline__ void qkt(f32x16&p0,f32x16&p1,const char*Kslot,const bf16x8*qr,const f32x16&negm,int r32,int hi){
  const char*kb=Kslot+hi*1024+r32*16;
  #pragma unroll
  for(int d0=(MODE==2?2:0);d0<(MODE==1?2:4);++d0){
    const bf16x8 b0=*reinterpret_cast<const bf16x8*>(kb+d0*2048);
    const bf16x8 b1=*reinterpret_cast<const bf16x8*>(kb+d0*2048+512);
    if(d0==(MODE==2?2:0)){p0=__builtin_amdgcn_mfma_f32_32x32x16_bf16(b0,qr[d0],negm,0,0,0);p1=__builtin_amdgcn_mfma_f32_32x32x16_bf16(b1,qr[d0],negm,0,0,0);}
    else{p0=__builtin_amdgcn_mfma_f32_32x32x16_bf16(b0,qr[d0],p0,0,0,0);p1=__builtin_amdgcn_mfma_f32_32x32x16_bf16(b1,qr[d0],p1,0,0,0);}}
}
typedef __attribute__((address_space(3))) const char* lds_cptr;
typedef short v4i16_t __attribute__((ext_vector_type(4)));
__device__ __forceinline__ void kload8(bf16x8*kf,lds_cptr kp){
  kf[0]=*(const __attribute__((address_space(3))) bf16x8*)(kp);      kf[1]=*(const __attribute__((address_space(3))) bf16x8*)(kp+512);
  kf[2]=*(const __attribute__((address_space(3))) bf16x8*)(kp+2048); kf[3]=*(const __attribute__((address_space(3))) bf16x8*)(kp+2560);
  kf[4]=*(const __attribute__((address_space(3))) bf16x8*)(kp+4096); kf[5]=*(const __attribute__((address_space(3))) bf16x8*)(kp+4608);
  kf[6]=*(const __attribute__((address_space(3))) bf16x8*)(kp+6144); kf[7]=*(const __attribute__((address_space(3))) bf16x8*)(kp+6656);
}
__device__ __forceinline__ void kload2(bf16x8*kf,lds_cptr kp,int j){ kf[2*j]=*(const __attribute__((address_space(3))) bf16x8*)(kp+j*2048); kf[2*j+1]=*(const __attribute__((address_space(3))) bf16x8*)(kp+j*2048+512); }
__device__ __forceinline__ s16x4 vtr(lds_cptr p){ return __builtin_bit_cast(s16x4,__builtin_amdgcn_ds_read_tr16_b64_v4i16((__attribute__((address_space(3))) v4i16_t*)p)); }
__device__ __forceinline__ float rowmax(const f32x16&p0,const f32x16&p1){
  float a=max3f(p0[0],p0[1],p1[0]),b=max3f(p0[2],p0[3],p1[1]);a=max3f(a,p1[2],p1[3]);
  #pragma unroll
  for(int r=4;r<16;r+=4){a=max3f(a,p0[r],p0[r+1]);b=max3f(b,p0[r+2],p0[r+3]);a=max3f(a,p1[r],p1[r+1]);b=max3f(b,p1[r+2],p1[r+3]);}
  const float m=max2f(a,b);
  auto rr=__builtin_amdgcn_permlane32_swap(__float_as_uint(m),__float_as_uint(m),false,false);
  return max2f(__uint_as_float(rr[0]),__uint_as_float(rr[1]));
}
__device__ __forceinline__ void pv(f32x16*o,int vb,bf16x8 pa0,bf16x8 pa1,bf16x8 pa2,bf16x8 pa3){
  #pragma unroll
  for(int d0=0;d0<2;++d0){s16x4 lo[4],hi[4];
    #pragma unroll
    for(int ks=0;ks<4;++ks){
      asm volatile("ds_read_b64_tr_b16 %0,%1 offset:%c2":"=&v"(lo[ks]):"v"(vb),"i"(d0*4096+ks*1024):"memory");
      asm volatile("ds_read_b64_tr_b16 %0,%1 offset:%c2":"=&v"(hi[ks]):"v"(vb),"i"(d0*4096+ks*1024+512):"memory");}
    asm volatile("s_waitcnt lgkmcnt(0)":::"memory");SBAR();
    #define PK(k) (bf16x8){lo[k][0],lo[k][1],lo[k][2],lo[k][3],hi[k][0],hi[k][1],hi[k][2],hi[k][3]}
    o[d0]=__builtin_amdgcn_mfma_f32_32x32x16_bf16(pa0,PK(0),o[d0],0,0,0);
    o[d0]=__builtin_amdgcn_mfma_f32_32x32x16_bf16(pa1,PK(1),o[d0],0,0,0);
    o[d0]=__builtin_amdgcn_mfma_f32_32x32x16_bf16(pa2,PK(2),o[d0],0,0,0);
    o[d0]=__builtin_amdgcn_mfma_f32_32x32x16_bf16(pa3,PK(3),o[d0],0,0,0);
    #undef PK
  }
}

#ifndef ATTN_STORE16
#define ATTN_STORE16(p,v) (*(u32x4*)(p)=(v))
#endif
template<int THRL,int MODE> __device__ __forceinline__ void attn_unit(const bf16*Qb,int ldq,const bf16*Kh,const bf16*Vh,bf16*Ob,int ldo,char*shm,const int tid_in,const float lam,const float post,const float*gsub){
  int tid_l=tid_in; asm volatile("":"+v"(tid_l));
  const int tid=tid_l,lane=tid&63,r32=lane&31,hi=lane>>5; const int wid=__builtin_amdgcn_readfirstlane(tid>>6);
  const bf16*Qw=Qb+(long)(wid*QBLK)*ldq;
  const unsigned lds0=(unsigned)(uintptr_t)shm;
  float*wsf=(float*)(shm+LDS_WS)+wid*64;
  const bf16*ksrc=Kh+(long)lane*ldk+wid*8;
  const bf16*vsrc=Vh+(long)(16*(wid&3)+(lane>>2))*ldv+(wid>>2)*32+(lane&3)*8;
  const unsigned kdst=lds0+LDS_K+wid*1024, vdst=lds0+LDS_V+wid*1024;
  #define DMA_K(t,slot) glds16(ksrc+(long)(t)*KVBLK*ldk,(unsigned)__builtin_amdgcn_readfirstlane(kdst+(slot)))
  #define DMA_V(t,slot) glds16(vsrc+(long)(t)*KVBLK*ldv,(unsigned)__builtin_amdgcn_readfirstlane(vdst+(slot)))
  const int vb0=(int)(lds0+LDS_V)+((lane>>4)&1)*32+(lane&3)*8+(4*hi+((lane&15)>>2))*64;
  const char*Kbase=shm+LDS_K; bf16x8 kf[8];
  const lds_cptr shm3=(lds_cptr)shm; const lds_cptr kp0=shm3+LDS_K+hi*1024+r32*16; const lds_cptr vp0=shm3+LDS_V+((lane>>4)&1)*32+(lane&3)*8+(4*hi+((lane&15)>>2))*64;
  constexpr int NT=SEQ/KVBLK;
  DMA_K(0,0);DMA_V(0,0);DMA_K(1,SLOTB);
  bf16x8 qr[4];
  #pragma unroll
  for(int d0=0;d0<4;++d0)qr[d0]=*reinterpret_cast<const bf16x8*>(&Qw[(long)r32*ldq+d0*16+hi*8]);
  float mhat=0.f,l_reg=0.f;f32x16 o[2];o[0]=f32x16{};o[1]=f32x16{};f32x16 negm=f32x16{};asm volatile("":"+v"(negm));
  #define CMASK(P0,P1,t) do{}while(0)
  bool resc=false;
  #define START(P0,P1) do{ const float rm=rowmax(P0,P1); resc=false; \
    { const float dl=rm; mhat=fadd_s(mhat,dl); \
      _Pragma("unroll") for(int r=0;r<16;++r){P0[r]=fsub_s(P0[r],dl);P1[r]=fsub_s(P1[r],dl);} \
      _Pragma("unroll") for(int r=0;r<16;++r)negm[r]=-mhat; asm volatile("":"+v"(negm)); } \
    _Pragma("unroll") for(int r=0;r<16;++r)P0[r]=__builtin_amdgcn_exp2f(P0[r]); }while(0)
  #define RESC() do{ if(resc){ asm volatile("s_waitcnt lgkmcnt(0)":::"memory"); \
      _Pragma("unroll") for(int d_=0;d_<2;++d_) _Pragma("unroll") for(int r=0;r<16;++r)o[d_][r]*=wsf[crow(r,hi)]; } }while(0)
  f32x16 pA0,pA1,pB0,pB1;
  int sl_prev=0,sl_cur=0,sl_next=SLOTB;
  #define ROT() do{sl_prev=sl_cur;sl_cur=sl_next;sl_next=(sl_next==(NSLOT-1)*SLOTB)?0:sl_next+SLOTB;}while(0)
  DMA_K(2,2*SLOTB);
  WAIT_BAR(3);
  qkt<MODE>(pA0,pA1,Kbase,qr,negm,r32,hi);asm volatile("s_nop 15\n\ts_nop 7":"+v"(pA0),"+v"(pA1));CMASK(pA0,pA1,0);
  START(pA0,pA1);
  _Pragma("unroll") for(int r=0;r<16;++r)pA1[r]=__builtin_amdgcn_exp2f(pA1[r]);
  WAIT_BAR(0);
  DMA_K(3,0);DMA_V(1,SLOTB);
  ROT();
  kload8(kf,kp0+sl_cur);
  WAIT_BAR(2);
  s16x4 vlo[8],vhi[8]; u32x4 pw0,pw1,pw2,pw3;
  #define PKW(P,B) cvtpk_s(P[B],P[B+1])
  #define PAF(k) __builtin_bit_cast(bf16x8,pw##k)
  #define VFR(i) (bf16x8){vlo[i][0],vlo[i][1],vlo[i][2],vlo[i][3],vhi[i][0],vhi[i][1],vhi[i][2],vhi[i][3]}
  #define PIN(x) asm volatile("":"+v"(x))
  #define MX3(a,b,c) __builtin_fmaxf(__builtin_fmaxf((a),(b)),(c))
  #define QKM(C,a,b,X) do{ if(MODE==0||(MODE==1&&(b)<2)||(MODE==2&&(b)>=2)){ C=__builtin_amdgcn_mfma_f32_32x32x16_bf16(kf[a],qr[b],((MODE==2&&(b)==2)?negm:(X)),0,0,0); } }while(0)
  #define GAPA(MF,A0,A1,A2,A3,W0,W1,PW) do{ MF; sacc+=A0; sacc+=A1; sacc+=A2; sacc+=A3; PIN(sacc); W0; W1; PIN(PW); SBAR(); }while(0)
  #define EX(v) __builtin_amdgcn_exp2f(v)
  #define GAPB(MF,X,B) do{ MF; X[B]=EX(X[B]); X[B+1]=EX(X[B+1]); X[B+2]=EX(X[B+2]); X[B+3]=EX(X[B+3]); PIN(X); SBAR(); }while(0)
  #define VRD(i) do{ vlo[i]=vtr(vp_+(((i)>>2)*4096+((i)&3)*1024)); vhi[i]=vtr(vp_+(((i)>>2)*4096+((i)&3)*1024+512)); }while(0)
  #define KRD(G,j) do{ if(G){ kload2(kf,kp0+sl_next,j); SBAR(); } }while(0)
  #define STEP(C0,C1,P0,P1,t,GK,GV,GL) do{ SBAR(); \
    const lds_cptr vp_=vp0+sl_prev; \
    VRD(0); SBAR(); float sacc=(P0[0]+P0[1]); \
    GAPA(QKM(C0,0,0,negm), P0[2],P0[3],P0[4],P0[5],     pw0[0]=PKW(P0,0), pw0[1]=PKW(P0,2), pw0); \
    VRD(4); SBAR(); GAPA(QKM(C1,1,0,negm), P0[6],P0[7],P0[8],P0[9],     pw0[2]=PKW(P0,4), pw0[3]=PKW(P0,6), pw0); \
    VRD(1); SBAR(); GAPA(QKM(C0,2,1,C0),   P0[10],P0[11],P0[12],P0[13], pw1[0]=PKW(P0,8), pw1[1]=PKW(P0,10), pw1); \
    VRD(5); SBAR(); GAPA(QKM(C1,3,1,C1),   P0[14],P0[15],P1[0],P1[1],   pw1[2]=PKW(P0,12),pw1[3]=PKW(P0,14), pw1); \
    VRD(2); SBAR(); GAPA(QKM(C0,4,2,C0),   P1[2],P1[3],P1[4],P1[5],     pw2[0]=PKW(P1,0), pw2[1]=PKW(P1,2), pw2); \
    VRD(6); SBAR(); GAPA(QKM(C1,5,2,C1),   P1[6],P1[7],P1[8],P1[9],     pw2[2]=PKW(P1,4), pw2[3]=PKW(P1,6), pw2); \
    VRD(3); SBAR(); GAPA(QKM(C0,6,3,C0),   P1[10],P1[11],P1[12],P1[13], pw3[0]=PKW(P1,8), pw3[1]=PKW(P1,10), pw3); \
    VRD(7); SBAR(); GAPA(QKM(C1,7,3,C1),   P1[14],P1[15],0.f,0.f,       pw3[2]=PKW(P1,12),pw3[3]=PKW(P1,14), pw3); \
    l_reg+=sacc; \
    if(GK){DMA_K((t)+3,sl_cur);} if(GV){DMA_V((t)+1,sl_next);} \
    CMASK(C0,C1,t); \
    { float a=MX3(C0[0],C0[1],C1[0]),b=MX3(C0[2],C0[3],C1[1]); a=MX3(a,C1[2],C1[3]); \
      _Pragma("unroll") for(int r=4;r<16;r+=4){a=MX3(a,C0[r],C0[r+1]);b=MX3(b,C0[r+2],C0[r+3]);a=MX3(a,C1[r],C1[r+1]);b=MX3(b,C1[r+2],C1[r+3]);} \
      float rm=__builtin_fmaxf(a,b); { auto rr=__builtin_amdgcn_permlane32_swap(__float_as_uint(rm),__float_as_uint(rm),false,false); rm=__builtin_fmaxf(__uint_as_float(rr[0]),__uint_as_float(rr[1])); } \
      resc=false; \
      if(__builtin_expect(__any(rm>(float)THRL),0)){ const float dl=__builtin_fmaxf(rm,0.f); mhat+=dl; \
        _Pragma("unroll") for(int r=0;r<16;++r){C0[r]-=dl;C1[r]-=dl;} \
        _Pragma("unroll") for(int r=0;r<16;++r)negm[r]=-mhat; asm volatile("":"+v"(negm)); \
        const float f=__builtin_amdgcn_exp2f(-dl); l_reg*=f; if(hi==0)wsf[r32]=f; resc=true; } } \
    SBAR(); \
    GAPB(o[0]=__builtin_amdgcn_mfma_f32_32x32x16_bf16(PAF(0),VFR(0),o[0],0,0,0), C0,0); \
    GAPB(o[1]=__builtin_amdgcn_mfma_f32_32x32x16_bf16(PAF(0),VFR(4),o[1],0,0,0), C0,4); \
    KRD(GL,0); GAPB(o[0]=__builtin_amdgcn_mfma_f32_32x32x16_bf16(PAF(1),VFR(1),o[0],0,0,0), C0,8); \
    KRD(GL,1); GAPB(o[1]=__builtin_amdgcn_mfma_f32_32x32x16_bf16(PAF(1),VFR(5),o[1],0,0,0), C0,12); \
    KRD(GL,2); GAPB(o[0]=__builtin_amdgcn_mfma_f32_32x32x16_bf16(PAF(2),VFR(2),o[0],0,0,0), C1,0); \
    KRD(GL,3); GAPB(o[1]=__builtin_amdgcn_mfma_f32_32x32x16_bf16(PAF(2),VFR(6),o[1],0,0,0), C1,4); \
    GAPB(o[0]=__builtin_amdgcn_mfma_f32_32x32x16_bf16(PAF(3),VFR(3),o[0],0,0,0), C1,8); \
    GAPB(o[1]=__builtin_amdgcn_mfma_f32_32x32x16_bf16(PAF(3),VFR(7),o[1],0,0,0), C1,12); \
    }while(0)
  int t=1;
  #undef CMASK
  #define CMASK(P0,P1,t) do{}while(0)
  for(;t+5<NT;t+=2){
    STEP(pB0,pB1,pA0,pA1,t,true,true,true);     WAIT_BAR(2); RESC(); ROT();
    STEP(pA0,pA1,pB0,pB1,t+1,true,true,true);   WAIT_BAR(2); RESC(); ROT();
  }
  #undef CMASK
  #define CMASK(P0,P1,t) do{}while(0)
  #define ENDW(tt) do{ if((tt)+3<NT){WAIT_BAR(2);} else if((tt)+2<NT){WAIT_BAR(1);} else {WAIT_BAR(0);} }while(0)
  for(;t+1<NT;t+=2){
    STEP(pB0,pB1,pA0,pA1,t,(t+3<NT),(t+1<NT),(t+1<NT));       ENDW(t);   RESC(); ROT();
    STEP(pA0,pA1,pB0,pB1,t+1,(t+4<NT),(t+2<NT),(t+2<NT));     ENDW(t+1); RESC(); ROT();
  }
  STEP(pB0,pB1,pA0,pA1,NT-1,false,false,false); RESC();
  { float sacc=pB0[0]+pB0[1]; _Pragma("unroll") for(int r=2;r<16;++r)sacc+=pB0[r]; _Pragma("unroll") for(int r=0;r<16;++r)sacc+=pB1[r]; l_reg+=sacc;
    pw0=(u32x4){PKW(pB0,0),PKW(pB0,2),PKW(pB0,4),PKW(pB0,6)};pw1=(u32x4){PKW(pB0,8),PKW(pB0,10),PKW(pB0,12),PKW(pB0,14)};pw2=(u32x4){PKW(pB1,0),PKW(pB1,2),PKW(pB1,4),PKW(pB1,6)};pw3=(u32x4){PKW(pB1,8),PKW(pB1,10),PKW(pB1,12),PKW(pB1,14)};
    SBAR(); pv(o,vb0+sl_cur,PAF(0),PAF(1),PAF(2),PAF(3)); }
  #undef PKW
  #undef PAF
  #undef VFR
  #undef PIN
  #undef MX3
  #undef GAPA
  #undef GAPB
  #undef EX
  #undef VRD
  #undef KRD
  #undef STEP
  #undef ENDW
  {auto rr=__builtin_amdgcn_permlane32_swap(__float_as_uint(l_reg),__float_as_uint(l_reg),false,false);l_reg=__uint_as_float(rr[0])+__uint_as_float(rr[1]);}
  if(hi==0)wsf[32+r32]=l_reg;asm volatile("s_waitcnt lgkmcnt(0)":::"memory");
  float rli[16];
  #pragma unroll
  for(int r=0;r<16;++r)rli[r]=__builtin_amdgcn_rcpf(wsf[32+crow(r,hi)]);
  bf16*Ow=Ob+(long)(wid*QBLK)*ldo;
  { bf16*stg=(bf16*)(shm+LDS_OST)+wid*2048;
    #pragma unroll
    for(int r=0;r<16;++r){const int orow=crow(r,hi);
      #pragma unroll
      for(int d0=0;d0<2;++d0)stg[orow*64+d0*32+r32]=__float2bfloat16(o[d0][r]*rli[r]);}
    asm volatile("s_waitcnt lgkmcnt(0)":::"memory");
    #pragma unroll
    for(int i_=0;i_<1;++i_){}
    bf16*stash=(bf16*)(shm+LDS_BYTES)+wid*2048;
    #pragma unroll
    for(int i=0;i<4;++i){const int row=i*8+(lane>>3),ch=lane&7; const u32x4 v=*(const u32x4*)(stg+row*64+ch*8);
      if(MODE==0){ATTN_STORE16(Ow+(long)row*ldo+ch*8,v);}
      else if(MODE==1){*(u32x4*)(stash+row*64+ch*8)=v;}
      else{const u32x4 v0=*(const u32x4*)(stash+row*64+ch*8); float x[8];
        #pragma unroll
        for(int j=0;j<4;++j){x[2*j]=__uint_as_float(v0[j]<<16)-lam*__uint_as_float(v[j]<<16); x[2*j+1]=__uint_as_float(v0[j]&0xffff0000u)-lam*__uint_as_float(v[j]&0xffff0000u);}
        float ss=0.f;
        #pragma unroll
        for(int j=0;j<8;++j)ss+=x[j]*x[j];
        ss+=bperm(lane^1,ss);ss+=bperm(lane^2,ss);ss+=bperm(lane^4,ss);
        const float rr=post/sqrtf(ss*(1.0f/64.0f)+1e-6f); u32x4 w;
        #pragma unroll
        for(int j=0;j<4;++j)w[j]=cvtpk_s(x[2*j]*rr*gsub[ch*8+2*j],x[2*j+1]*rr*gsub[ch*8+2*j+1]);
        ATTN_STORE16(Ow+(long)row*ldo+ch*8,w);} } }
  asm volatile("s_waitcnt lgkmcnt(0)\n\ts_barrier":::"memory");
  #undef DMA_K
  #undef DMA_V
  #undef CMASK
  #undef START
  #undef RESC
  #undef ROT
}
constexpr int ATTN_LDS_BYTES=LDS_BYTES;
#undef SBAR
#undef WAIT_BAR
}

#define GAS __attribute__((address_space(1)))
#define LAS __attribute__((address_space(3)))
typedef unsigned short bf16;
typedef unsigned v4u __attribute__((ext_vector_type(4)));
typedef float f32x4 __attribute__((ext_vector_type(4)));
typedef short bf16x8 __attribute__((ext_vector_type(8)));
typedef GAS unsigned gu32;
typedef GAS unsigned long long gu64;
#define RLX_AGENT __ATOMIC_RELAXED, __HIP_MEMORY_SCOPE_AGENT
#define LDS_WAIT() asm volatile("s_waitcnt lgkmcnt(0)" ::: "memory")
#define VM_WAIT() asm volatile("s_waitcnt vmcnt(0)" ::: "memory")
__device__ __forceinline__ unsigned long long rt() { return __builtin_amdgcn_s_memrealtime(); }
__device__ __forceinline__ unsigned f2bf(float f) { unsigned u = __builtin_bit_cast(unsigned, f); return (u + 0x7fffu + ((u >> 16) & 1u)) >> 16; }
__device__ __forceinline__ unsigned pk2(float lo, float hi) { return f2bf(lo) | (f2bf(hi) << 16); }

#define XB_TMO      128
#define XB_XCNT(j)  (256  + 64 * (j))
#define XB_XSUB(j)  (1280 + 64 * (j))
#define XB_XGEN(j)  (2304 + 64 * (j))
#define XB_TOP      3328
#define XB_TOPGEN   3392
#define XCD_BAR_WORDS 3456
#define XB_SPIN_CAP (1u << 18)

__device__ __forceinline__ unsigned xb_ld(unsigned* p)              { return __hip_atomic_load(p, __ATOMIC_RELAXED, __HIP_MEMORY_SCOPE_AGENT); }
__device__ __forceinline__ unsigned xb_add(unsigned* p, unsigned v) { return __hip_atomic_fetch_add(p, v, __ATOMIC_RELAXED, __HIP_MEMORY_SCOPE_AGENT); }
__device__ __forceinline__ unsigned xb_xcc_id() { return (unsigned)__builtin_amdgcn_s_getreg((3 << 11) | 20) & 0xFu; }
#define XB_SPIN(cond, bar) do { unsigned _sp = 0; while (cond) { __builtin_amdgcn_s_sleep(1); \
    if ((++_sp & 255u) == 0u) { if (xb_ld(&(bar)[XB_TMO])) break; if (_sp > XB_SPIN_CAP) { atomicAdd(&(bar)[XB_TMO], 1u); break; } } } } while (0)

struct XcdBarrier {
    unsigned* bar; unsigned x;
    volatile LAS unsigned* st;
};

__device__ __forceinline__ XcdBarrier xcd_barrier_post(unsigned* bar, volatile LAS unsigned* st) {
    XcdBarrier b; b.bar = bar; b.x = xb_xcc_id(); b.st = st;
    if (threadIdx.x == 0) (void)xb_add(&bar[XB_XCNT(b.x)], 1u);
    return b;
}
__device__ __forceinline__ void xcd_barrier_complete(unsigned* bar, unsigned x, unsigned& nloc, unsigned& nx) {
    const unsigned G = gridDim.x * gridDim.y * gridDim.z;
    unsigned sum, cnt, mine, sp = 0u;
    for (;;) {
        sum = 0u; cnt = 0u; mine = 0u;
#pragma unroll
        for (unsigned j = 0; j < 16; ++j) { const unsigned c = xb_ld(&bar[XB_XCNT(j)]); sum += c; cnt += (c > 0u) ? 1u : 0u; mine = (j == x) ? c : mine; }
        if (sum == G) break;
        __builtin_amdgcn_s_sleep(1);
        if ((++sp & 255u) == 0u) { if (xb_ld(&bar[XB_TMO])) break; if (sp > XB_SPIN_CAP) { atomicAdd(&bar[XB_TMO], 1u); break; } }
    }
    nloc = mine > 0u ? mine : 1u; nx = cnt > 0u ? cnt : 1u;
}

__device__ __forceinline__ void xcd_barrier(const XcdBarrier& b) {
    asm volatile("s_waitcnt vmcnt(0)" ::: "memory");
    __syncthreads();
    if (threadIdx.x == 0) {
        unsigned* bar = b.bar; unsigned xq = b.x; asm volatile("" : "+s"(bar), "+s"(xq));
        __builtin_amdgcn_s_waitcnt(0);
        unsigned nloc = b.st[0], nx = b.st[1];
        if (nloc == 0u) { xcd_barrier_complete(bar, xq, nloc, nx); b.st[0] = nloc; b.st[1] = nx; }
        const unsigned old = xb_add(&bar[XB_XSUB(xq)], 1u);
        const unsigned gen = old / nloc;
        if (old + 1u == (gen + 1u) * nloc) {
            __builtin_amdgcn_fence(__ATOMIC_RELEASE, "agent");
            asm volatile("s_waitcnt vmcnt(0)" ::: "memory");
            const unsigned og = xb_add(&bar[XB_TOP], 1u);
            const unsigned tg = og / nx;
            if (og + 1u == (tg + 1u) * nx) xb_add(&bar[XB_TOPGEN], 1u);
            else XB_SPIN(xb_ld(&bar[XB_TOPGEN]) == tg, bar);
            __builtin_amdgcn_fence(__ATOMIC_ACQUIRE, "agent");
            xb_add(&bar[XB_XGEN(xq)], 1u);
            asm volatile("s_waitcnt vmcnt(0)" ::: "memory");
        } else {
            XB_SPIN(xb_ld(&bar[XB_XGEN(xq)]) == gen, bar);
            __builtin_amdgcn_fence(__ATOMIC_ACQUIRE, "agent");
            asm volatile("s_waitcnt vmcnt(0)" ::: "memory");
        }
    }
    __syncthreads();
}

constexpr int NWAVES = 8, NTHR = 512;
constexpr int BATCH = 2, SEQ = 8192, DM = 1024, MROWS = BATCH * SEQ, DEPTH = 2;
constexpr int D_IN = 2576, NPROJ = 2560, DFF = 2816, NFF = 5632;
constexpr int P_MLQ = 0, P_MLK = 256, P_MLV = 512, P_MLO = 768, P_POOL = 1024, P_DQ = 1280, P_DK = 1536, P_DV = 1792, P_GQ = 2048, P_GK = 2304, P_GV = 2432;
constexpr float LOG2E = 1.4426950408889634f;
constexpr float C2D = 0.17677669529663687f * LOG2E;
constexpr float C2G = 0.125f * LOG2E;
constexpr float C2X = 0.0625f * LOG2E;
constexpr size_t MiB = 1u << 20;
constexpr size_t WS_CTL = 0, CTL_ZERO_BYTES = 1 * MiB;
constexpr size_t WS_ROPE = 1 * MiB;
constexpr size_t WS_SSQ = 2 * MiB;
constexpr size_t WS_HSSQ = 3 * MiB;
constexpr size_t WS_PSUM = 4 * MiB;
constexpr size_t WS_GATES = 5 * MiB;
constexpr size_t WS_MLSC = 6 * MiB;
constexpr size_t WS_WG = 6 * MiB + 256 * 1024;
constexpr size_t WS_NLOC = 7 * MiB;
constexpr size_t WS_MEMN = 8 * MiB;
constexpr size_t WS_KVRAW = 10 * MiB;
constexpr size_t WS_KM = 18 * MiB;
constexpr size_t WS_VMT = 20 * MiB;
constexpr size_t WS_W = 22 * MiB, W_LAYER = 32 * MiB;
constexpr size_t W_IN = 0, W_OUT = 5 * MiB, W_CQ = 7 * MiB, W_CKV = 9 * MiB, W_CO = 13 * MiB, W_FI = 15 * MiB, W_FO = 26 * MiB;
constexpr size_t WS_XB = 86 * MiB;
constexpr size_t WS_BIG = 118 * MiB;
constexpr size_t WS_PROJ = WS_BIG, WS_DQP = WS_BIG + 80 * MiB, WS_YCAT = WS_BIG + 96 * MiB;
constexpr size_t WS_CQ = WS_BIG, WS_PT = WS_BIG + 32 * MiB, WS_CO = WS_BIG + 64 * MiB;
constexpr size_t WS_ACT = WS_BIG;
constexpr size_t WS_END = 256 * MiB;
static_assert(WS_YCAT + 32 * MiB <= WS_END && WS_ACT + 88 * MiB <= WS_END, "d_ws map");
constexpr int CW_BAR = 4096;
constexpr int RING_OFF = 0, RING_BYTES = 131072;
constexpr int LDSCTL_OFF = RING_BYTES, MISC_OFF = LDSCTL_OFF + 320;
constexpr int LDS_BYTES = 147456;

typedef unsigned v2u __attribute__((ext_vector_type(2)));
typedef float f32x2 __attribute__((ext_vector_type(2)));
typedef short bf16x8_t __attribute__((ext_vector_type(8)));
__device__ __forceinline__ float bflo(unsigned u) { return __uint_as_float(u << 16); }
__device__ __forceinline__ float bfhi(unsigned u) { return __uint_as_float(u & 0xffff0000u); }
__device__ __forceinline__ float bf1(bf16 u) { return __uint_as_float((unsigned)u << 16); }
__device__ __forceinline__ float wave_sum_(float v, int lane) {
#pragma unroll
    for (int o = 1; o < 64; o <<= 1) v += SHX(v, o);
    return v;
}
__device__ __forceinline__ float wave_max_(float v, int lane) {
#pragma unroll
    for (int o = 1; o < 64; o <<= 1) v = fmaxf(v, SHX(v, o));
    return v;
}
#define wave_sum(v) wave_sum_((v), lane)
#define wave_max(v) wave_max_((v), lane)
__device__ __forceinline__ float scan_add(float v, int lane) {
#pragma unroll
    for (int o = 1; o < 64; o <<= 1) { const float t = SHU(v, o); v = (lane >= o) ? v + t : v; }
    return v;
}
__device__ __forceinline__ float scan_max_up(float v, int lane) {
#pragma unroll
    for (int o = 1; o < 64; o <<= 1) { const float t = SHU(v, o); v = (lane >= o) ? fmaxf(v, t) : v; }
    return v;
}
__device__ __forceinline__ float scan_max_down(float v, int lane) {
#pragma unroll
    for (int o = 1; o < 64; o <<= 1) { const float t = SHD(v, o); v = (lane + o < 64) ? fmaxf(v, t) : v; }
    return v;
}
__device__ __forceinline__ float logsig(float x) { return fminf(x, 0.f) - log1pf(expf(-fabsf(x))); }

struct Args { const float* in[28]; float* out; unsigned char* ws; int ph_lo, ph_hi; };

__device__ __forceinline__ void tr_item(const float* W, int Nsrc, int K, int src_col0, bf16* WT, int dst_row0, const float* gk, float scale, LAS float* scr, int kb, int lane) {
    const int k0 = 64 * kb;
    float wv_[32];
#pragma unroll
    for (int i = 0; i < 32; ++i) wv_[i] = W[(size_t)(k0 + 2 * i + (lane >> 5)) * Nsrc + src_col0 + (lane & 31)];
#pragma unroll
    for (int i = 0; i < 32; ++i) { const int kk = 2 * i + (lane >> 5); const float g = gk ? gk[k0 + kk] * scale : scale; scr[kk * 33 + (lane & 31)] = wv_[i] * g; }
    LDS_WAIT(); asm volatile("" ::: "memory");
    const int c = lane & 7;
#pragma unroll
    for (int j = 0; j < 4; ++j) { const int n = (lane >> 3) + 8 * j; const LAS float* s = scr + (8 * c) * 33 + n;
        v4u o; o.x = pk2(s[0 * 33], s[1 * 33]); o.y = pk2(s[2 * 33], s[3 * 33]); o.z = pk2(s[4 * 33], s[5 * 33]); o.w = pk2(s[6 * 33], s[7 * 33]);
        *(v4u*)(WT + (size_t)(dst_row0 + n) * K + k0 + 8 * c) = o; }
    LDS_WAIT(); asm volatile("" ::: "memory");
}
constexpr int CONV_ITEMS = 16 * 80 + 16 * 32 * 3 + 16 * 64 + 16 * 176 + 44 * 32, CONV_SPLIT = 5000;
__device__ __forceinline__ void convert_weights(const __attribute__((address_space(4))) Args* ap, LAS unsigned char* lds, int l, int w0, int nw, int wave, int lane, int it_lo, int it_hi, bool do_wg) {
    unsigned char* ws = ap->ws;
    LAS float* scr = (LAS float*)(lds + RING_OFF + wave * 16384);
    constexpr int I_IN = 16 * 80, I_OUT = 16 * 32, I_CQ = 16 * 32, I_CKV = 16 * 64, I_CO = 16 * 32, I_FI = 16 * 176, I_FO = 44 * 32;
    constexpr int I_LAYER = I_IN + I_OUT + I_CQ + I_CKV + I_CO + I_FI + I_FO;
    static_assert(I_LAYER == CONV_ITEMS, "item count");
    for (int it = it_lo + w0; it < it_hi; it += nw) {
        int r = it;
        unsigned char* wl = ws + WS_W + (size_t)l * W_LAYER;
        if (r < I_IN) { const int kb = r / 80, nb = r % 80, d0 = 32 * nb;
            tr_item(ap->in[3] + (size_t)l * 1024 * D_IN, D_IN, 1024, d0 + (d0 >= 1024 ? 16 : 0), (bf16*)(wl + W_IN), d0, ap->in[2] + l * 1024, (d0 >= 256 && d0 < 512) ? 0.125f : 1.0f, scr, kb, lane); continue; } r -= I_IN;
        if (r < I_OUT) { tr_item(ap->in[15] + (size_t)l * 1024 * 1024, 1024, 1024, 32 * (r % 32), (bf16*)(wl + W_OUT), 32 * (r % 32), nullptr, 1.0f, scr, r / 32, lane); continue; } r -= I_OUT;
        if (r < I_CQ) { tr_item(ap->in[18] + (size_t)l * 1024 * 1024, 1024, 1024, 32 * (r % 32), (bf16*)(wl + W_CQ), 32 * (r % 32), ap->in[16] + l * 1024, 1.0f, scr, r / 32, lane); continue; } r -= I_CQ;
        if (r < I_CKV) { tr_item(ap->in[19] + (size_t)l * 1024 * 2048, 2048, 1024, 32 * (r % 64), (bf16*)(wl + W_CKV), 32 * (r % 64), nullptr, 1.0f, scr, r / 64, lane); continue; } r -= I_CKV;
        if (r < I_CO) { tr_item(ap->in[22] + (size_t)l * 1024 * 1024, 1024, 1024, 32 * (r % 32), (bf16*)(wl + W_CO), 32 * (r % 32), nullptr, 1.0f, scr, r / 32, lane); continue; } r -= I_CO;
        if (r < I_FI) { const int kb = r / 176, nb = r % 176, d0 = 32 * nb, tile = d0 >> 8, within = d0 & 255;
            const int src = within < 128 ? 128 * tile + within : DFF + 128 * tile + (within - 128);
            tr_item(ap->in[24] + (size_t)l * 1024 * NFF, NFF, 1024, src, (bf16*)(wl + W_FI), d0, ap->in[23] + l * 1024, 1.0f, scr, kb, lane); continue; } r -= I_FI;
        tr_item(ap->in[27] + (size_t)l * DFF * 1024, 1024, DFF, 32 * (r % 32), (bf16*)(wl + W_FO), 32 * (r % 32), nullptr, 1.0f, scr, r / 32, lane);
    }
    if (do_wg) { bf16* WG = (bf16*)(ws + WS_WG) + (size_t)l * 2 * 16384; const float* Win = ap->in[3] + (size_t)l * 1024 * D_IN; const float* gm = ap->in[2] + l * 1024;
      for (int e = w0 * 64 + lane; e < 16384; e += nw * 64) { const int k = e >> 4, j = e & 15; const float v = Win[(size_t)k * D_IN + 1024 + j] * gm[k]; const unsigned h = f2bf(v);
          WG[j * 1024 + k] = (bf16)h; WG[16384 + j * 1024 + k] = (bf16)f2bf(v - __uint_as_float(h << 16)); } }
}
__device__ __forceinline__ void p0_prologue(const __attribute__((address_space(4))) Args* ap, LAS unsigned char* lds, int vcu, int G, int wave, int lane, int tid) {
    unsigned char* ws = ap->ws;
    const int gw = vcu * NWAVES + wave, NGW = G * NWAVES;
    convert_weights(ap, lds, 0, gw, NGW, wave, lane, 0, CONV_ITEMS, true);
    { const float* x = ap->in[0]; bf16* XB = (bf16*)(ws + WS_XB); float* SSQ = (float*)(ws + WS_SSQ);
      for (int m = gw; m < MROWS; m += NGW) { const f32x4* xr = (const f32x4*)(x + (size_t)m * DM) + lane; float s = 0.f;
          unsigned long long* o8 = (unsigned long long*)(XB + (size_t)m * DM) + lane;
#pragma unroll
          for (int j = 0; j < 4; ++j) { const f32x4 v = xr[64 * j]; s += (v[0] * v[0] + v[1] * v[1]) + (v[2] * v[2] + v[3] * v[3]);
              o8[64 * j] = (unsigned long long)pk2(v[0], v[1]) | ((unsigned long long)pk2(v[2], v[3]) << 32); }
          s = wave_sum(s); if (lane < 16) SSQ[(size_t)m * 16 + lane] = (lane == 0) ? s : 0.f; } }
    { const float* mem = ap->in[1]; bf16* MEMN = (bf16*)(ws + WS_MEMN);
      for (int idx = gw; idx < DEPTH * 512; idx += NGW) { const int l = idx >> 9, r = idx & 511; const f32x4* xr = (const f32x4*)(mem + (size_t)r * DM) + lane; const f32x4* gr = (const f32x4*)(ap->in[17] + l * DM) + lane;
          f32x4 v[4]; float s = 0.f;
#pragma unroll
          for (int j = 0; j < 4; ++j) { v[j] = xr[64 * j]; s += (v[j][0] * v[j][0] + v[j][1] * v[j][1]) + (v[j][2] * v[j][2] + v[j][3] * v[j][3]); }
          const float rs = 1.0f / sqrtf(wave_sum(s) * (1.0f / 1024.0f) + 1e-6f);
          unsigned long long* o8 = (unsigned long long*)(MEMN + (size_t)idx * DM) + lane;
#pragma unroll
          for (int j = 0; j < 4; ++j) { const f32x4 g = gr[64 * j]; o8[64 * j] = (unsigned long long)pk2(v[j][0] * rs * g[0], v[j][1] * rs * g[1]) | ((unsigned long long)pk2(v[j][2] * rs * g[2], v[j][3] * rs * g[3]) << 32); } } }
    { float2* RT = (float2*)(ws + WS_ROPE);
      for (int e = vcu * NTHR + tid; e < SEQ * 16; e += G * NTHR) { const int pos = e >> 4, i = e & 15;
          double inv = 1.0; for (int q = 0; q < i; ++q) inv *= 0.56234132519034908;
          const double rev = (double)pos * inv * 0.15915494309189535; double fr = rev - floor(rev); if (fr > 0.5) fr -= 1.0;
          const float ang = (float)(fr * 6.283185307179586);
          RT[e] = make_float2(cosf(ang), sinf(ang)); } }
}

__device__ __forceinline__ void gates_phase(const bf16* XB, const bf16* WG, const float* SSQ, float* GATES, int gw, int NGW, int lane) {
    const int r = lane & 15, q = lane >> 4;
    for (int tt = gw; tt < MROWS / 16; tt += NGW) {
        const bf16* xa = XB + (size_t)(tt * 16 + r) * DM + 8 * q; const bf16* wh = WG + r * 1024 + 8 * q; const bf16* wl_ = wh + 16384;
        f32x4 acc = (f32x4){0.f, 0.f, 0.f, 0.f};
#pragma unroll 8
        for (int kk = 0; kk < 32; ++kk) { const bf16x8_t a = *(const bf16x8_t*)(xa + 32 * kk), bh = *(const bf16x8_t*)(wh + 32 * kk), bl = *(const bf16x8_t*)(wl_ + 32 * kk);
            acc = __builtin_amdgcn_mfma_f32_16x16x32_bf16(a, bh, acc, 0, 0, 0); acc = __builtin_amdgcn_mfma_f32_16x16x32_bf16(a, bl, acc, 0, 0, 0); }
#pragma unroll
        for (int i = 0; i < 4; ++i) { const int t = tt * 16 + 4 * q + i; const float rs = 1.0f / sqrtf(pg8::sum16(SSQ + (size_t)t * 16) * (1.0f / 1024.0f) + 1e-6f); GATES[(size_t)t * 16 + r] = acc[i] * rs; }
    }
}

struct QKRaw { unsigned dqa, dqb, dka, dkb, gqa, gqb; bf16 gk1, gk2; float2 dcs0, dcs1, qcs0, qcs1, kcs; };
template <bool DIFF, bool GQA> __device__ __forceinline__ void qk_load(int t, const bf16* PROJ, const float2* RT, int lane, QKRaw& w) {
    const int pos = t & (SEQ - 1), prow = pos >> 6, pcol = pos & 63; const bf16* pr = PROJ + (size_t)t * NPROJ;
    if (DIFF) { const int grp = lane >> 3, i = 2 * (lane & 7); w.dcs0 = RT[pos * 16 + i]; w.dcs1 = RT[pos * 16 + i + 1];
      const bf16* p = pr + P_DQ + grp * 32; w.dqa = *(const unsigned*)(p + i); w.dqb = *(const unsigned*)(p + 16 + i);
      const bf16* k = pr + P_DK + grp * 32; w.dka = *(const unsigned*)(k + i); w.dkb = *(const unsigned*)(k + 16 + i); }
    if (GQA) { const int head = lane >> 4, sub = lane & 15, half = sub >> 3, i = 2 * (sub & 7); const int pp = half ? pcol : prow; w.qcs0 = RT[pp * 16 + i]; w.qcs1 = RT[pp * 16 + i + 1];
      const bf16* p = pr + P_GQ + head * 64 + half * 32; w.gqa = *(const unsigned*)(p + i); w.gqb = *(const unsigned*)(p + 16 + i); }
    if (GQA) { const int head = lane >> 5, sub = lane & 31, half = sub >> 4, i = sub & 15; const int pp = half ? pcol : prow; w.kcs = RT[pp * 16 + i];
      const bf16* p = pr + P_GK + head * 64 + half * 32; w.gk1 = p[i]; w.gk2 = p[16 + i]; }
}
template <bool DIFF, bool GQA> __device__ __forceinline__ void qk_finish(int t, bf16* PROJ, bf16* DQP, const float* dqn, const float* dkn, const float* gqn, const float* gkn, int lane, const QKRaw& w) {
    bf16* pr = PROJ + (size_t)t * NPROJ;
    if (DIFF) {
        const int grp = lane >> 3, i = 2 * (lane & 7); const float2 cs0 = w.dcs0, cs1 = w.dcs1;
#pragma unroll
        for (int which = 0; which < 2; ++which) {
            bf16* p = pr + (which ? P_DK : P_DQ) + grp * 32; const float* gn = which ? dkn : dqn;
            const unsigned ua = which ? w.dka : w.dqa, ub = which ? w.dkb : w.dqb;
            float x1a = bflo(ua), x1b = bfhi(ua), x2a = bflo(ub), x2b = bfhi(ub);
            float ss = (x1a * x1a + x1b * x1b) + (x2a * x2a + x2b * x2b); ss += SHX(ss, 1); ss += SHX(ss, 2); ss += SHX(ss, 4);
            const float r = 1.0f / sqrtf(ss * (1.0f / 32.0f) + 1e-6f);
            x1a *= r * gn[i]; x1b *= r * gn[i + 1]; x2a *= r * gn[16 + i]; x2b *= r * gn[17 + i];
            float y1a = x1a * cs0.x - x2a * cs0.y, y2a = x2a * cs0.x + x1a * cs0.y, y1b = x1b * cs1.x - x2b * cs1.y, y2b = x2b * cs1.x + x1b * cs1.y;
            if (which == 0) { bf16* q = DQP + (size_t)t * 512 + grp * 64; const int qo = (grp & 1) * 32, zo = 32 - qo;
                *(unsigned*)(q + qo + i) = pk2(y1a * C2D, y1b * C2D); *(unsigned*)(q + qo + 16 + i) = pk2(y2a * C2D, y2b * C2D);
                *(unsigned long long*)(q + zo + 4 * (lane & 7)) = 0ull; }
            else { *(unsigned*)(p + i) = pk2(y1a, y1b); *(unsigned*)(p + 16 + i) = pk2(y2a, y2b); }
        }
    }
    if (GQA) {
        const int head = lane >> 4, sub = lane & 15, half = sub >> 3, i = 2 * (sub & 7); const float2 cs0 = w.qcs0, cs1 = w.qcs1;
        bf16* p = pr + P_GQ + head * 64 + half * 32; const float* gn = gqn + half * 32;
        float x1a = bflo(w.gqa), x1b = bfhi(w.gqa), x2a = bflo(w.gqb), x2b = bfhi(w.gqb);
        float ss = (x1a * x1a + x1b * x1b) + (x2a * x2a + x2b * x2b); ss += SHX(ss, 1); ss += SHX(ss, 2); ss += SHX(ss, 4); ss += SHX(ss, 8);
        const float r = C2G / sqrtf(ss * (1.0f / 64.0f) + 1e-6f);
        x1a *= r * gn[i]; x1b *= r * gn[i + 1]; x2a *= r * gn[16 + i]; x2b *= r * gn[17 + i];
        *(unsigned*)(p + i) = pk2(x1a * cs0.x - x2a * cs0.y, x1b * cs1.x - x2b * cs1.y); *(unsigned*)(p + 16 + i) = pk2(x2a * cs0.x + x1a * cs0.y, x2b * cs1.x + x1b * cs1.y);
    }
    if (GQA) {
        const int head = lane >> 5, sub = lane & 31, half = sub >> 4, i = sub & 15; const float2 cs = w.kcs;
        bf16* p = pr + P_GK + head * 64 + half * 32; const float* gn = gkn + half * 32;
        float x1 = bf1(w.gk1), x2 = bf1(w.gk2);
        float ss = x1 * x1 + x2 * x2; ss += SHX(ss, 1); ss += SHX(ss, 2); ss += SHX(ss, 4); ss += SHX(ss, 8); ss += SHX(ss, 16);
        const float r = 1.0f / sqrtf(ss * (1.0f / 64.0f) + 1e-6f);
        x1 *= r * gn[i]; x2 *= r * gn[16 + i];
        p[i] = (bf16)f2bf(x1 * cs.x - x2 * cs.y); p[16 + i] = (bf16)f2bf(x2 * cs.x + x1 * cs.y);
    }
}

constexpr int LP = 72;
__device__ __forceinline__ void mm_16x32(const LAS bf16* A, const LAS bf16* Bt, int tr, int tc0, int lane, f32x4& d0, f32x4& d1) {
    const int r = lane & 15, q = lane >> 4;
    const LAS bf16* ap = A + (16 * tr + r) * LP + 8 * q; const LAS bf16* b0 = Bt + (16 * tc0 + r) * LP + 8 * q; const LAS bf16* b1 = b0 + 16 * LP;
#pragma unroll
    for (int kk = 0; kk < 2; ++kk) { const bf16x8_t a = *(const LAS bf16x8_t*)(ap + 32 * kk), x0 = *(const LAS bf16x8_t*)(b0 + 32 * kk), x1 = *(const LAS bf16x8_t*)(b1 + 32 * kk);
        d0 = __builtin_amdgcn_mfma_f32_16x16x32_bf16(a, x0, d0, 0, 0, 0); d1 = __builtin_amdgcn_mfma_f32_16x16x32_bf16(a, x1, d1, 0, 0, 0); }
}
__device__ __forceinline__ void st_bf16(LAS bf16* p, float v) { *p = (bf16)f2bf(v); }
__device__ __forceinline__ void load_tile_b(LAS bf16* dst, const bf16* src, int tid) { const int r = tid >> 3, c8 = (tid & 7) * 8; *(LAS v4u*)(dst + r * LP + c8) = *(const v4u*)(src + (size_t)r * NPROJ + c8); }
__device__ __forceinline__ void load_tile_bT(LAS bf16* dst, const bf16* src, int tid) { const int r = tid & 63, c8 = (tid >> 6) * 8;
    const v4u raw = *(const v4u*)(src + (size_t)r * NPROJ + c8);
    dst[(c8 + 0) * LP + r] = (bf16)(raw.x & 0xffffu); dst[(c8 + 1) * LP + r] = (bf16)(raw.x >> 16); dst[(c8 + 2) * LP + r] = (bf16)(raw.y & 0xffffu); dst[(c8 + 3) * LP + r] = (bf16)(raw.y >> 16);
    dst[(c8 + 4) * LP + r] = (bf16)(raw.z & 0xffffu); dst[(c8 + 5) * LP + r] = (bf16)(raw.z >> 16); dst[(c8 + 6) * LP + r] = (bf16)(raw.w & 0xffffu); dst[(c8 + 7) * LP + r] = (bf16)(raw.w >> 16); }
__device__ __forceinline__ void pool_item(LAS unsigned char* lds, int item, const bf16* PROJ, const float* pw, const float* pscale, bf16* YCAT, int tid) {
    const int tile = item >> 2, g = item & 3, win = 2 << g, lane = tid & 63, wave = tid >> 6;
    const int trow0 = tile * 64, pos0 = trow0 & (SEQ - 1);
    LAS float* U = (LAS float*)lds;
    LAS bf16* PB = (LAS bf16*)(U + 80 * 64);
    LAS bf16* WgT = PB + 64 * LP;
    for (int e = tid; e < 640; e += NTHR) { const int jj = e >> 3, c8 = (e & 7) * 8; const int p = pos0 - 8 + jj;
        v4u raw = (v4u){0u, 0u, 0u, 0u};
        if (p >= 0 && p < SEQ) raw = *(const v4u*)(PROJ + (size_t)(trow0 - 8 + jj) * NPROJ + P_POOL + g * 64 + c8);
        LAS float* d = U + jj * 64 + c8; d[0] = bflo(raw.x); d[1] = bfhi(raw.x); d[2] = bflo(raw.y); d[3] = bfhi(raw.y); d[4] = bflo(raw.z); d[5] = bfhi(raw.z); d[6] = bflo(raw.w); d[7] = bfhi(raw.w); }
    { const int c = tid & 63, e8 = (tid >> 6) * 8; const f32x4 a = *(const f32x4*)(pw + g * 4096 + c * 64 + e8), b = *(const f32x4*)(pw + g * 4096 + c * 64 + e8 + 4);
#pragma unroll
      for (int j = 0; j < 4; ++j) { st_bf16(WgT + (e8 + j) * LP + c, a[j]); st_bf16(WgT + (e8 + 4 + j) * LP + c, b[j]); } }
    __syncthreads();
    { const int tl = tid >> 3, c8 = (tid & 7) * 8, pos = pos0 + tl;
      int lo = pos - win / 2, hi = pos - win / 2 + win - 1; lo = lo < 0 ? 0 : lo; hi = hi > SEQ - 1 ? SEQ - 1 : hi;
      float s[8];
#pragma unroll
      for (int q = 0; q < 8; ++q) s[q] = 0.f;
      for (int p = lo; p <= hi; ++p) { const LAS float* u = U + (p - pos0 + 8) * 64 + c8;
#pragma unroll
          for (int q = 0; q < 8; ++q) s[q] += u[q]; }
      const float inv = 1.0f / (float)(hi - lo + 1); const LAS float* uc = U + (tl + 8) * 64 + c8;
      v4u o; o.x = pk2(s[0] * inv - uc[0], s[1] * inv - uc[1]); o.y = pk2(s[2] * inv - uc[2], s[3] * inv - uc[3]); o.z = pk2(s[4] * inv - uc[4], s[5] * inv - uc[5]); o.w = pk2(s[6] * inv - uc[6], s[7] * inv - uc[7]);
      *(LAS v4u*)(PB + tl * LP + c8) = o; }
    __syncthreads();
    { const int tr = wave >> 1, tc0 = (wave & 1) * 2, q = lane >> 4, cl = lane & 15; f32x4 y[2]; y[0] = (f32x4){0.f, 0.f, 0.f, 0.f}; y[1] = y[0];
      mm_16x32(PB, WgT, tr, tc0, lane, y[0], y[1]);
#pragma unroll
      for (int x = 0; x < 2; ++x) { const int e = 16 * (tc0 + x) + cl; const float sc = pscale[g * 64 + e];
#pragma unroll
          for (int i = 0; i < 4; ++i) YCAT[(size_t)(trow0 + 16 * tr + 4 * q + i) * DM + 256 + g * 64 + e] = (bf16)f2bf(y[x][i] * sc); } }
    __syncthreads();
}
__device__ __forceinline__ void ml_gates(const float* GATES, const float* bi, const float* bfz, int trow0, int h, int lane, float& lfF, float& liF, float& lfB, float& liB) {
    const float* g = GATES + (size_t)(trow0 + lane) * 16;
    liF = g[h] + bi[h]; lfF = logsig(g[4 + h] + bfz[h]); liB = g[8 + h] + bi[4 + h]; lfB = logsig(g[12 + h] + bfz[4 + h]);
}
__device__ __forceinline__ void load_tile_T(LAS float* dstT, const bf16* src, int tid) {
    const int r = tid >> 3, c8 = (tid & 7) * 8; const v4u raw = *(const v4u*)(src + (size_t)r * NPROJ + c8);
    dstT[(c8 + 0) * 64 + r] = bflo(raw.x); dstT[(c8 + 1) * 64 + r] = bfhi(raw.x); dstT[(c8 + 2) * 64 + r] = bflo(raw.y); dstT[(c8 + 3) * 64 + r] = bfhi(raw.y);
    dstT[(c8 + 4) * 64 + r] = bflo(raw.z); dstT[(c8 + 5) * 64 + r] = bfhi(raw.z); dstT[(c8 + 6) * 64 + r] = bflo(raw.w); dstT[(c8 + 7) * 64 + r] = bfhi(raw.w);
}
__device__ __forceinline__ void load_tile(LAS float* dst, const bf16* src, int tid) {
    const int r = tid >> 3, c8 = (tid & 7) * 8; const v4u raw = *(const v4u*)(src + (size_t)r * NPROJ + c8); LAS float* d = dst + r * 64 + c8;
    d[0] = bflo(raw.x); d[1] = bfhi(raw.x); d[2] = bflo(raw.y); d[3] = bfhi(raw.y); d[4] = bflo(raw.z); d[5] = bfhi(raw.z); d[6] = bflo(raw.w); d[7] = bfhi(raw.w);
}
__device__ __forceinline__ void ml_local_item(LAS unsigned char* lds, int item, const bf16* PROJ, const float* GATES, const float* bi, const float* bfz, float* CLOC, float* NLOC, float* GG, float* MLOC, int tid) {
    const int b = item >> 9, h = (item >> 7) & 3, c = item & 127, trow0 = b * SEQ + c * 64, lane = tid & 63, wave = tid >> 6;
    LAS bf16* kwF = (LAS bf16*)lds; LAS bf16* kwB = kwF + 64 * LP; LAS bf16* vT = kwB + 64 * LP; LAS float* wS = (LAS float*)(vT + 64 * LP);
    const int seqF = (b * 4 + h) * 2;
    load_tile_bT(vT, PROJ + (size_t)trow0 * NPROJ + P_MLV + h * 64, tid);
    if (wave == 0) { float lfF, liF, lfB, liB; ml_gates(GATES, bi, bfz, trow0, h, lane, lfF, liF, lfB, liB);
        const float bF = scan_add(lfF, lane), gF = SHI(bF, 63), aF = gF - bF + liF, mF = wave_max(aF);
        const float pB = scan_add(lfB, lane), gB = SHI(pB, 63), bB = gB - pB + lfB, aB = gB - bB + liB, mB = wave_max(aB);
        wS[2 * lane] = expf(aF - mF); wS[2 * lane + 1] = expf(aB - mB);
        if (lane == 0) { GG[seqF * 128 + c] = gF; MLOC[seqF * 128 + c] = mF; GG[(seqF + 1) * 128 + c] = gB; MLOC[(seqF + 1) * 128 + c] = mB; } }
    __syncthreads();
    { const int r = tid & 63, c8 = (tid >> 6) * 8; const v4u raw = *(const v4u*)(PROJ + (size_t)(trow0 + r) * NPROJ + P_MLK + h * 64 + c8); const float wf = wS[2 * r], wb = wS[2 * r + 1];
      const float kv[8] = {bflo(raw.x), bfhi(raw.x), bflo(raw.y), bfhi(raw.y), bflo(raw.z), bfhi(raw.z), bflo(raw.w), bfhi(raw.w)};
#pragma unroll
      for (int j = 0; j < 8; ++j) { st_bf16(kwF + (c8 + j) * LP + r, kv[j] * wf); st_bf16(kwB + (c8 + j) * LP + r, kv[j] * wb); } }
    __syncthreads();
    { const int tr = wave >> 1, tc0 = (wave & 1) * 2, q = lane >> 4, cl = lane & 15; f32x4 cf[2], cb[2]; cf[0] = (f32x4){0.f, 0.f, 0.f, 0.f}; cf[1] = cf[0]; cb[0] = cf[0]; cb[1] = cf[0];
      mm_16x32(kwF, vT, tr, tc0, lane, cf[0], cf[1]); mm_16x32(kwB, vT, tr, tc0, lane, cb[0], cb[1]);
      float* oF = CLOC + (size_t)(seqF * 128 + c) * 4096; float* oB = CLOC + (size_t)((seqF + 1) * 128 + c) * 4096;
#pragma unroll
      for (int x = 0; x < 2; ++x)
#pragma unroll
          for (int i = 0; i < 4; ++i) { const int o = (16 * tr + 4 * q + i) * 64 + 16 * (tc0 + x) + cl; oF[o] = cf[x][i]; oB[o] = cb[x][i]; } }
    { const int d = tid >> 3, seg = tid & 7; const v4u a = *(const LAS v4u*)(kwF + d * LP + 8 * seg), bq = *(const LAS v4u*)(kwB + d * LP + 8 * seg);
      float nf = ((bflo(a.x) + bfhi(a.x)) + (bflo(a.y) + bfhi(a.y))) + ((bflo(a.z) + bfhi(a.z)) + (bflo(a.w) + bfhi(a.w)));
      float nb = ((bflo(bq.x) + bfhi(bq.x)) + (bflo(bq.y) + bfhi(bq.y))) + ((bflo(bq.z) + bfhi(bq.z)) + (bflo(bq.w) + bfhi(bq.w)));
      nf += SHX(nf, 1); nf += SHX(nf, 2); nf += SHX(nf, 4); nb += SHX(nb, 1); nb += SHX(nb, 2); nb += SHX(nb, 4);
      if (seg == 0) { NLOC[(size_t)(seqF * 128 + c) * 64 + d] = nf; NLOC[(size_t)((seqF + 1) * 128 + c) * 64 + d] = nb; } }
    __syncthreads();
}
__device__ __forceinline__ void mem_post_row(int idx, const float* KVRAW, const float* cqn, const float* ckn, bf16* KM, bf16* VMT, int lane) {
    const int l = idx >> 9, r = idx & 511, b = r >> 8, key = r & 255; const float* raw = KVRAW + (size_t)idx * 2048;
    const f32x4 gq = *(const f32x4*)(cqn + l * 256 + 4 * lane), gk = *(const f32x4*)(ckn + l * 256 + 4 * lane);
#pragma unroll
    for (int h = 0; h < 4; ++h) { const f32x4 k4 = *(const f32x4*)(raw + h * 256 + 4 * lane);
        const float ss = wave_sum((k4[0] * k4[0] + k4[1] * k4[1]) + (k4[2] * k4[2] + k4[3] * k4[3])); const float rr = C2X / sqrtf(ss * (1.0f / 256.0f) + 1e-6f);
        v2u w; w.x = pk2(k4[0] * rr * gk[0] * gq[0], k4[1] * rr * gk[1] * gq[1]); w.y = pk2(k4[2] * rr * gk[2] * gq[2], k4[3] * rr * gk[3] * gq[3]);
        const size_t hb = (size_t)((l * 2 + b) * 4 + h) * 65536;
        *(v2u*)(KM + hb + (size_t)key * 256 + 4 * lane) = w;
        const f32x4 v4 = *(const f32x4*)(raw + 1024 + h * 256 + 4 * lane);
#pragma unroll
        for (int j = 0; j < 4; ++j) VMT[hb + (size_t)(4 * lane + j) * 256 + key] = (bf16)f2bf(v4[j]); }
}
__device__ __forceinline__ void ml_scan(float* CLOC, float* NLOC, const float* GG, const float* MLOC, float* MPREV, int gw, int NGW, int lane) {
    for (int w = gw; w < 16 * 65; w += NGW) {
        const int seq = w / 65, part = w % 65; const bool bwd = (seq & 1) != 0;
        float* base = part < 64 ? CLOC + (size_t)seq * 128 * 4096 + part * 64 : NLOC + (size_t)seq * 128 * 64;
        const long cs = part < 64 ? 4096 : 64; const long stride = bwd ? -cs : cs; float* p0 = base + (bwd ? 127 * cs : 0);
        const int c0 = bwd ? 127 - lane : lane, c1 = bwd ? 63 - lane : 64 + lane;
        const float gg0 = GG[seq * 128 + c0], gg1 = GG[seq * 128 + c1], ml0 = MLOC[seq * 128 + c0], ml1 = MLOC[seq * 128 + c1];
        float loc[128];
        { float* pl = p0;
#pragma unroll
          for (int k = 0; k < 128; ++k) { loc[k] = pl[lane]; pl += stride; asm volatile("" : "+s"(pl)); } }
        float* ps = p0;
        float C = 0.f, m = 0.f; float mp0 = 0.f, mp1 = 0.f;
#pragma unroll
        for (int k = 0; k < 128; ++k) {
            const float g = __int_as_float(__builtin_amdgcn_readlane(__float_as_int(k < 64 ? gg0 : gg1), k & 63)), mlv = __int_as_float(__builtin_amdgcn_readlane(__float_as_int(k < 64 ? ml0 : ml1), k & 63));
            ps[lane] = C; ps += stride; asm volatile("" : "+s"(ps)); if (k < 64) mp0 = (lane == (k & 63)) ? m : mp0; else mp1 = (lane == (k & 63)) ? m : mp1;
            const float mn = fmaxf(g + m, mlv); const float fo = __expf(g + m - mn), fl = __expf(mlv - mn); C = fo * C + fl * loc[k]; m = mn;
        }
        if (part == 64) { MPREV[seq * 128 + c0] = mp0; MPREV[seq * 128 + c1] = mp1; }
    }
}
__device__ __forceinline__ void ml_out_item(LAS unsigned char* lds, int item, const bf16* PROJ, const float* GATES, const float* bi, const float* bfz, const float* CLOC, const float* NLOC, const float* MPREV, const float* gnorm, bf16* YCAT, int tid) {
    const int b = item >> 9, h = (item >> 7) & 3, c = item & 127, trow0 = b * SEQ + c * 64, lane = tid & 63, wave = tid >> 6;
    LAS bf16* qb = (LAS bf16*)lds; LAS bf16* kb = qb + 64 * LP; LAS bf16* vT = kb + 64 * LP; LAS bf16* CpT = vT + 64 * LP; LAS bf16* Wb = CpT + 2 * 64 * LP;
    LAS float* HB = (LAS float*)(Wb + 2 * 64 * LP);
    LAS float* VB = HB + 4096;
    LAS float* VLI = VB + 128;
    LAS float* MT = VLI + 128; LAS float* SI = MT + 128; LAS float* NP = SI + 128; LAS float* INV = NP + 128;
    const bf16* prow = PROJ + (size_t)trow0 * NPROJ; const size_t sc0 = (size_t)((b * 4 + h) * 2) * 128 + c, sc1 = sc0 + 128;
    load_tile_b(qb, prow + P_MLQ + h * 64, tid); load_tile_b(kb, prow + P_MLK + h * 64, tid); load_tile_bT(vT, prow + P_MLV + h * 64, tid);
    { const int d = tid & 63, e8 = (tid >> 6) * 8;
#pragma unroll
      for (int dir = 0; dir < 2; ++dir) { const float* src = CLOC + (dir ? sc1 : sc0) * 4096 + d * 64 + e8; const f32x4 a = *(const f32x4*)src, bq = *(const f32x4*)(src + 4); LAS bf16* dst = CpT + dir * 64 * LP;
#pragma unroll
          for (int j = 0; j < 4; ++j) { st_bf16(dst + (e8 + j) * LP + d, a[j]); st_bf16(dst + (e8 + 4 + j) * LP + d, bq[j]); } } }
    if (tid < 128) NP[tid] = NLOC[((tid >> 6) ? sc1 : sc0) * 64 + (tid & 63)];
    if (wave == 0) { float lfF, liF, lfB, liB; ml_gates(GATES, bi, bfz, trow0, h, lane, lfF, liF, lfB, liB);
        const float bF = scan_add(lfF, lane); const float pB = scan_add(lfB, lane), gB = SHI(pB, 63), bB = gB - pB + lfB;
        VB[lane] = bF; VB[64 + lane] = bB; VLI[lane] = liF; VLI[64 + lane] = liB;
        const float pmF = scan_max_up(liF - bF, lane), pmB = scan_max_down(liB - bB, lane);
        const float eF = bF + MPREV[sc0], mtF = fmaxf(eF, bF + pmF), eB = bB + MPREV[sc1], mtB = fmaxf(eB, bB + pmB);
        MT[lane] = mtF; SI[lane] = expf(eF - mtF); MT[64 + lane] = mtB; SI[64 + lane] = expf(eB - mtB); }
    const int tr = wave >> 1, tc0 = (wave & 1) * 2, q4 = lane >> 4, cl = lane & 15;
    __syncthreads();
    {
        f32x4 sacc[2]; sacc[0] = (f32x4){0.f, 0.f, 0.f, 0.f}; sacc[1] = sacc[0];
        mm_16x32(qb, kb, tr, tc0, lane, sacc[0], sacc[1]);
#pragma unroll
        for (int dir = 0; dir < 2; ++dir)
#pragma unroll
            for (int x = 0; x < 2; ++x) { const int s_ = 16 * (tc0 + x) + cl; const float us = VLI[dir * 64 + s_] - VB[dir * 64 + s_];
#pragma unroll
                for (int i = 0; i < 4; ++i) { const int t = 16 * tr + 4 * q4 + i; const bool ok = dir ? (s_ >= t) : (s_ <= t);
                    st_bf16(Wb + dir * 64 * LP + t * LP + s_, ok ? __expf(VB[dir * 64 + t] + us - MT[dir * 64 + t]) * sacc[x][i] : 0.f); } }
    }
    __syncthreads();
    {
        const int row = tid >> 3, seg = tid & 7; const v4u qq = *(const LAS v4u*)(qb + row * LP + 8 * seg);
#pragma unroll
        for (int dir = 0; dir < 2; ++dir) { const v4u w = *(const LAS v4u*)(Wb + dir * 64 * LP + row * LP + 8 * seg); const LAS float* np = NP + dir * 64 + 8 * seg;
            float dw = ((bflo(w.x) + bfhi(w.x)) + (bflo(w.y) + bfhi(w.y))) + ((bflo(w.z) + bfhi(w.z)) + (bflo(w.w) + bfhi(w.w)));
            float qn = (bflo(qq.x) * np[0] + bfhi(qq.x) * np[1]) + (bflo(qq.y) * np[2] + bfhi(qq.y) * np[3]) + (bflo(qq.z) * np[4] + bfhi(qq.z) * np[5]) + (bflo(qq.w) * np[6] + bfhi(qq.w) * np[7]);
            dw += SHX(dw, 1); dw += SHX(dw, 2); dw += SHX(dw, 4); qn += SHX(qn, 1); qn += SHX(qn, 2); qn += SHX(qn, 4);
            if (seg == 0) INV[dir * 64 + row] = 1.0f / fmaxf(fabsf(dw + SI[dir * 64 + row] * qn), expf(-MT[dir * 64 + row])); }
    }
    f32x4 nw[2][2], in_[2][2];
#pragma unroll
    for (int dir = 0; dir < 2; ++dir) { nw[dir][0] = (f32x4){0.f, 0.f, 0.f, 0.f}; nw[dir][1] = nw[dir][0]; in_[dir][0] = nw[dir][0]; in_[dir][1] = nw[dir][0];
        mm_16x32(Wb + dir * 64 * LP, vT, tr, tc0, lane, nw[dir][0], nw[dir][1]); mm_16x32(qb, CpT + dir * 64 * LP, tr, tc0, lane, in_[dir][0], in_[dir][1]); }
    __syncthreads();
#pragma unroll
    for (int i = 0; i < 4; ++i) { const int t = 16 * tr + 4 * q4 + i; const float si0 = SI[t], inv0 = INV[t], si1 = SI[64 + t], inv1 = INV[64 + t];
#pragma unroll
        for (int x = 0; x < 2; ++x) HB[t * 64 + 16 * (tc0 + x) + cl] = (nw[0][x][i] + si0 * in_[0][x][i]) * inv0 + (nw[1][x][i] + si1 * in_[1][x][i]) * inv1; }
    __syncthreads();
    const int t0 = (tid >> 4) * 2, x0 = (tid & 15) * 4;
    const f32x4 gn = *(const f32x4*)(gnorm + h * 64 + x0);
#pragma unroll
    for (int i = 0; i < 2; ++i) { const f32x4 hv = *(const LAS f32x4*)(HB + (t0 + i) * 64 + x0); float ss = (hv[0] * hv[0] + hv[1] * hv[1]) + (hv[2] * hv[2] + hv[3] * hv[3]);
        ss += SHX(ss, 1); ss += SHX(ss, 2); ss += SHX(ss, 4); ss += SHX(ss, 8);
        const float r = 1.0f / sqrtf(ss * (1.0f / 64.0f) + 1e-6f);
        const v2u og = *(const v2u*)(prow + (size_t)(t0 + i) * NPROJ + P_MLO + h * 64 + x0);
        const float o0 = bflo(og.x), o1 = bfhi(og.x), o2 = bflo(og.y), o3 = bfhi(og.y);
        const float y0 = hv[0] * r * gn[0] / (1.0f + expf(-o0)), y1 = hv[1] * r * gn[1] / (1.0f + expf(-o1)), y2 = hv[2] * r * gn[2] / (1.0f + expf(-o2)), y3 = hv[3] * r * gn[3] / (1.0f + expf(-o3));
        v2u w; w.x = pk2(y0, y1); w.y = pk2(y2, y3); *(v2u*)(YCAT + (size_t)(trow0 + t0 + i) * DM + h * 64 + x0) = w; }
    __syncthreads();
}
__device__ __forceinline__ void diff_combine(const bf16* DQP, const float* lamp, const float* gsub, float lam_init, bf16* YCAT, int gw, int NGW, int lane) {
    float p1 = 0.f, p2 = 0.f; if (lane < 32) { p1 = lamp[lane] * lamp[32 + lane]; p2 = lamp[64 + lane] * lamp[96 + lane]; }
    const float lam = expf(wave_sum(p1)) - expf(wave_sum(p2)) + lam_init;
    const int head = lane >> 4, d4 = (lane & 15) * 4; const f32x4 g = *(const f32x4*)(gsub + d4); const float post = 1.0f - lam_init;
    for (int t = gw; t < MROWS; t += NGW) { const bf16* p = DQP + (size_t)t * 512 + head * 128 + d4; const v2u a = *(const v2u*)p, bq = *(const v2u*)(p + 64);
        const float x0 = bflo(a.x) - lam * bflo(bq.x), x1 = bfhi(a.x) - lam * bfhi(bq.x), x2 = bflo(a.y) - lam * bflo(bq.y), x3 = bfhi(a.y) - lam * bfhi(bq.y);
        float ss = (x0 * x0 + x1 * x1) + (x2 * x2 + x3 * x3); ss += SHX(ss, 1); ss += SHX(ss, 2); ss += SHX(ss, 4); ss += SHX(ss, 8);
        const float r = post / sqrtf(ss * (1.0f / 64.0f) + 1e-6f);
        v2u w; w.x = pk2(x0 * r * g[0], x1 * r * g[1]); w.y = pk2(x2 * r * g[2], x3 * r * g[3]); *(v2u*)(YCAT + (size_t)t * DM + 512 + head * 64 + d4) = w; }
}

typedef const __attribute__((address_space(4))) Args* KArgs;
__device__ __forceinline__ KArgs kargs() { KArgs p = (KArgs)__builtin_amdgcn_kernarg_segment_ptr(); asm volatile("" : "+s"(p)); return p; }
#define WSP(T, off) ((T*)(ws + (off)))
#ifndef REP_VALU
#define REP_VALU 1
#endif
#ifndef REP_ATT
#define REP_ATT 1
#endif
#ifndef REP_GEMM
#define REP_GEMM 1
#endif
#ifndef REP_FFI
#define REP_FFI 1
#endif
#ifndef REP_X
#define REP_X 1
#endif
#ifndef REP_GATES
#define REP_GATES 1
#endif
#ifndef DRY_QK
#define DRY_QK 0
#endif
#ifndef DRY_SCAN
#define DRY_SCAN 0
#endif
#ifndef REP_F
#define REP_F 1
#endif
#ifndef REP_PRO
#define REP_PRO 1
#endif
#define LTID int tid_l; asm volatile("v_mbcnt_lo_u32_b32 %0, -1, 0\n\tv_mbcnt_hi_u32_b32 %0, -1, %0" : "=v"(tid_l)); tid_l += wv * 64; const int tid = tid_l
__global__ void __launch_bounds__(NTHR, 2) hybrid_fwd(Args args_unused) {
    extern __shared__ __attribute__((aligned(16))) unsigned char lds_raw[];
    LAS unsigned char* lds = (LAS unsigned char*)lds_raw;
    const int wv = __builtin_amdgcn_readfirstlane((int)threadIdx.x >> 6);
    const int G = gridDim.x; const int bx = blockIdx.x; const int vcu = (G % 8 == 0) ? (bx % 8) * (G / 8) + bx / 8 : bx;
    { LTID; for (int u = tid; u < (LDS_BYTES - LDSCTL_OFF) / 4; u += NTHR) ((LAS unsigned*)(lds + LDSCTL_OFF))[u] = 0u; }
    __syncthreads();
    XcdBarrier bar; bar.bar = (unsigned*)((gu32*)(kargs()->ws + WS_CTL) + CW_BAR); bar.x = 0u; bar.st = (volatile LAS unsigned*)(lds + MISC_OFF) + 8;
    const int lo = kargs()->ph_lo, hi = kargs()->ph_hi;
#define IN(k) (lo <= (k) && (k) < hi)
#ifndef PHMASK
#define PHMASK 0xFFFF
#endif
#define PHON(k) (((PHMASK) >> (k)) & 1)
#ifndef PROF_SUB
#define PROF_SUB (-1)
#endif
#define SUBT(n) do { if (PROF_SUB >= 0 && l == 0) { __syncthreads(); if (PROF_SUB == (n)) tp0 = __builtin_amdgcn_s_memrealtime(); if (PROF_SUB + 1 == (n)) tp1 = __builtin_amdgcn_s_memrealtime(); } } while (0)
#ifndef PROF_LO
#define PROF_LO (-1)
#define PROF_HI (-1)
#endif
    unsigned long long tp0 = 0ull, tp1 = 0ull;
#define SEAM(k) do { if (IN(k) && IN((k) + 1)) xcd_barrier(bar); if (PROF_LO >= 0) { if ((k) == PROF_LO - 1) tp0 = __builtin_amdgcn_s_memrealtime(); if ((k) == PROF_HI) tp1 = __builtin_amdgcn_s_memrealtime(); } } while (0)
#define WAVE_IDS LTID; const int lane = tid & 63, wave = __builtin_amdgcn_readfirstlane(tid >> 6), gw = vcu * NWAVES + wave, NGW = G * NWAVES; (void)lane; (void)gw; (void)NGW

    if (PHON(12) && IN(0)) { { WAVE_IDS; if (bx == 0) for (int i = tid; i < XCD_BAR_WORDS; i += NTHR) __hip_atomic_store((unsigned*)((gu32*)(kargs()->ws + WS_CTL) + CW_BAR) + i, 0u, __ATOMIC_RELAXED, __HIP_MEMORY_SCOPE_AGENT);
        for (int rep_ = 0; rep_ < REP_PRO; ++rep_) p0_prologue(kargs(), lds, vcu, G, wave, lane, tid); } __threadfence(); cg::this_grid().sync(); }
    bar = xcd_barrier_post((unsigned*)((gu32*)(kargs()->ws + WS_CTL) + CW_BAR), (volatile LAS unsigned*)(lds + MISC_OFF) + 8);

#pragma unroll 1
    for (int l = 0; l < DEPTH; ++l) {
        const int P = 1 + 12 * l;
        if (PHON(0) && IN(P + 0)) {
            { KArgs ap = kargs(); unsigned char* ws = ap->ws; LTID; pg8::GemmK1024 g{WSP(bf16, WS_XB), (const bf16*)(ws + WS_W + (size_t)l * W_LAYER + W_IN)}; pg8::StaticOrder S; S.init(MROWS / 256, 8, G, bx);
              pg8::EpiScaled E{WSP(bf16, WS_PROJ), NPROJ, WSP(float, WS_SSQ), nullptr};
              for (int rep_ = 0; rep_ < REP_GEMM; ++rep_) pg8::gemm_phase<pg8::GemmK1024, pg8::EpiScaled, pg8::StaticOrder, true, true, false>(lds + RING_OFF, g, S, E, tid); }
            { KArgs ap = kargs(); unsigned char* ws = ap->ws; WAVE_IDS; gates_phase(WSP(bf16, WS_XB), WSP(bf16, WS_WG) + (size_t)l * 2 * 16384, WSP(float, WS_SSQ), WSP(float, WS_GATES), gw, NGW, lane); }
        }
        SEAM(P + 0);
        if (PHON(1) && IN(P + 1)) {
            { KArgs ap = kargs(); unsigned char* ws = ap->ws; LTID; pg8::GemmK1024 g{WSP(bf16, WS_XB), (const bf16*)(ws + WS_W + (size_t)l * W_LAYER + W_IN)}; pg8::StaticOrder S; S.init(MROWS / 256, 2, G, bx, 8);
              pg8::EpiScaled E{WSP(bf16, WS_PROJ), NPROJ, WSP(float, WS_SSQ), nullptr};
              pg8::gemm_phase<pg8::GemmK1024, pg8::EpiScaled, pg8::StaticOrder, true, true, false>(lds + RING_OFF, g, S, E, tid); }
            {
                { const int ll = l; KArgs ap = kargs(); unsigned char* ws = ap->ws;
                    LTID; pg8::GemmK1024 g{WSP(bf16, WS_MEMN) + (size_t)ll * 512 * DM, (const bf16*)(ws + WS_W + (size_t)ll * W_LAYER + W_CKV)};
                    pg8::StaticOrder S; S.init(2, 8, G, (bx + G - 128) % G); pg8::EpiF32 E{WSP(float, WS_KVRAW) + (size_t)ll * 512 * 2048, 2048};
                    pg8::gemm_phase<pg8::GemmK1024, pg8::EpiF32, pg8::StaticOrder, true, true, false>(lds + RING_OFF, g, S, E, tid); }
            }
            int first, count, stride;
            if (G == 256) { if (bx < 144) { first = bx * 3; count = 3; } else { const int j = bx - 144; first = 432 + 5 * j + (j < 32 ? j : 32); count = 5 + (j < 32 ? 1 : 0); } stride = 1; } else { first = bx; count = (1024 - bx + G - 1) / G; stride = G; }
            { KArgs ap = kargs(); unsigned char* ws = ap->ws; WAVE_IDS;
              { bf16* PROJ = WSP(bf16, WS_PROJ); bf16* DQP = WSP(bf16, WS_DQP); const float2* RT = WSP(const float2, WS_ROPE);
                for (int j = 0; j < count; ++j) { const int t0 = (first + j * stride) * 16 + wave * 2; QKRaw w[2];
#pragma unroll
                    for (int u = 0; u < 2; ++u) qk_load<true, false>(t0 + u, PROJ, RT, lane, w[u]);
#pragma unroll
                    for (int u = 0; u < 2; ++u) qk_finish<true, false>(t0 + u, PROJ, DQP, ap->in[9] + l * 32, ap->in[10] + l * 32, ap->in[13] + l * 64, ap->in[14] + l * 64, lane, w[u]); } }
 }
            { KArgs ap = kargs(); unsigned char* ws = ap->ws; float* GG = WSP(float, WS_MLSC); LTID;
              for (int j = 0; j < count; ++j) ml_local_item(lds + RING_OFF, first + j * stride, WSP(bf16, WS_PROJ), WSP(float, WS_GATES), ap->in[4] + l * 8, ap->in[5] + l * 8, ap->out, WSP(float, WS_NLOC), GG, GG + 2048, tid); }
            { KArgs ap = kargs(); unsigned char* ws = ap->ws; LTID;
              for (int j = 0; j < count; ++j) pool_item(lds + RING_OFF, first + j * stride, WSP(bf16, WS_PROJ), ap->in[7] + (size_t)l * 16384, ap->in[8] + l * 256, WSP(bf16, WS_YCAT), tid); }
        }
        SEAM(P + 1);
        if (PHON(2) && IN(P + 2)) { KArgs ap = kargs(); unsigned char* ws = ap->ws; WAVE_IDS; float* GG = WSP(float, WS_MLSC);
            for (int idx = l * 512 + gw; idx < (l + 1) * 512; idx += NGW) mem_post_row(idx, WSP(float, WS_KVRAW), ap->in[20], ap->in[21], WSP(bf16, WS_KM), WSP(bf16, WS_VMT), lane);
            { bf16* PROJ = WSP(bf16, WS_PROJ); const float2* RT = WSP(const float2, WS_ROPE);
              int qw = gw, qn = NGW; if (NGW > 16 * 65) { if (l + 1 < DEPTH) { qw = gw; qn = 16 * 65; if (gw >= 16 * 65) qw = MROWS; } else { qw = gw - 16 * 65; qn = NGW - 16 * 65; if (gw < 16 * 65) qw = MROWS; } }
              for (int t0 = qw * 2; t0 < MROWS; t0 += qn * 2) { QKRaw w[2];
#pragma unroll
                  for (int u = 0; u < 2; ++u) qk_load<false, true>(t0 + u, PROJ, RT, lane, w[u]);
#pragma unroll
                  for (int u = 0; u < 2; ++u) qk_finish<false, true>(t0 + u, PROJ, nullptr, ap->in[9] + l * 32, ap->in[10] + l * 32, ap->in[13] + l * 64, ap->in[14] + l * 64, lane, w[u]); } }
            ml_scan(ap->out, WSP(float, WS_NLOC), GG, GG + 2048, GG + 4096, gw, NGW, lane);
            if (l + 1 < DEPTH) { if (NGW > 16 * 65) { constexpr int CUT = (CONV_ITEMS * 7) / 8;
                    if (gw >= 16 * 65) convert_weights(ap, lds, l + 1, gw - 16 * 65, NGW - 16 * 65, wave, lane, 0, CUT, true); else convert_weights(ap, lds, l + 1, gw, 16 * 65, wave, lane, CUT, CONV_ITEMS, false); }
                else convert_weights(ap, lds, l + 1, gw, NGW, wave, lane, 0, CONV_ITEMS, true); } }
        SEAM(P + 2);
        if (PHON(3) && IN(P + 3)) {
            { KArgs ap = kargs(); unsigned char* ws = ap->ws; float* GG = WSP(float, WS_MLSC); LTID;
              for (int it = vcu; it < 1024; it += G) ml_out_item(lds + RING_OFF, it, WSP(bf16, WS_PROJ), WSP(float, WS_GATES), ap->in[4] + l * 8, ap->in[5] + l * 8, ap->out, WSP(float, WS_NLOC), GG + 4096, ap->in[6] + l * 256, WSP(bf16, WS_YCAT), tid); }
#pragma unroll 1
            for (int u = vcu; u < 256; u += G) {
                KArgs ap = kargs(); unsigned char* ws = ap->ws; LTID; bf16* PROJ = WSP(bf16, WS_PROJ); bf16* DQP = WSP(bf16, WS_DQP); bf16* YCAT = WSP(bf16, WS_YCAT);
                const int b = u >> 7, hh = (u >> 5) & 3, qb = u & 31; const size_t r0 = (size_t)b * SEQ, rq = r0 + (size_t)qb * 256;
                const float lam_init = 0.8f - 0.6f * expf(-0.3f * (float)l); const float* lamp = ap->in[11] + l * 128; const int lane = tid & 63;
                float p1 = 0.f, p2 = 0.f; if (lane < 32) { p1 = lamp[lane] * lamp[32 + lane]; p2 = lamp[64 + lane] * lamp[96 + lane]; }
                const float lam = expf(wave_sum(p1)) - expf(wave_sum(p2)) + lam_init;
                attn_body::attn_unit<8, 0>((const attn_body::bf16*)(PROJ + rq * NPROJ + P_GQ + hh * 64), NPROJ, (const attn_body::bf16*)(PROJ + r0 * NPROJ + P_GK + (hh >> 1) * 64), (const attn_body::bf16*)(PROJ + r0 * NPROJ + P_GV + (hh >> 1) * 64),
                                           (attn_body::bf16*)(YCAT + rq * DM + 768 + hh * 64), DM, (char*)lds_raw + RING_OFF, tid, 0.f, 0.f, nullptr);
                attn_body::attn_unit<8, 1>((const attn_body::bf16*)(DQP + rq * 512 + (2 * hh) * 64), 512, (const attn_body::bf16*)(PROJ + r0 * NPROJ + P_DK + hh * 64), (const attn_body::bf16*)(PROJ + r0 * NPROJ + P_DV + hh * 64),
                                           (attn_body::bf16*)nullptr, 0, (char*)lds_raw + RING_OFF, tid, 0.f, 0.f, nullptr);
                attn_body::attn_unit<8, 2>((const attn_body::bf16*)(DQP + rq * 512 + (2 * hh + 1) * 64), 512, (const attn_body::bf16*)(PROJ + r0 * NPROJ + P_DK + hh * 64), (const attn_body::bf16*)(PROJ + r0 * NPROJ + P_DV + hh * 64),
                                           (attn_body::bf16*)(YCAT + rq * DM + 512 + hh * 64), DM, (char*)lds_raw + RING_OFF, tid, lam, 1.0f - lam_init, ap->in[12] + l * 64);
            }
        }
        SEAM(P + 3);
        if (PHON(5) && IN(P + 5)) { KArgs ap = kargs(); unsigned char* ws = ap->ws; const float* xin = (l == 0) ? ap->in[0] : (const float*)nullptr;
            LTID; pg8::GemmK1024 g{WSP(bf16, WS_YCAT), (const bf16*)(ws + WS_W + (size_t)l * W_LAYER + W_OUT)}; pg8::StaticOrder S; S.init(MROWS / 256, 4, G, bx);
            pg8::EpiRes E{xin, nullptr, WSP(bf16, WS_XB), WSP(float, WS_SSQ)}; for (int rep_ = 0; rep_ < ((l == 0) ? REP_F : 1); ++rep_) pg8::gemm_phase<pg8::GemmK1024, pg8::EpiRes, pg8::StaticOrder, true, true, false>(lds + RING_OFF, g, S, E, tid); }
        SEAM(P + 5);
        if (PHON(6) && IN(P + 6)) { KArgs ap = kargs(); unsigned char* ws = ap->ws; LTID; pg8::GemmK1024 g{WSP(bf16, WS_XB), (const bf16*)(ws + WS_W + (size_t)l * W_LAYER + W_CQ)}; pg8::StaticOrder S; S.init(MROWS / 256, 4, G, bx);
            pg8::EpiScaled E{WSP(bf16, WS_CQ), DM, WSP(float, WS_SSQ), WSP(float, WS_HSSQ)}; for (int rep_ = 0; rep_ < REP_GEMM; ++rep_) pg8::gemm_phase<pg8::GemmK1024, pg8::EpiScaled, pg8::StaticOrder, true, true, false>(lds + RING_OFF, g, S, E, tid); }
        if (PHON(7) && IN(P + 7)) { KArgs ap = kargs(); unsigned char* ws = ap->ws; LTID; pg8::GemmHeads g{WSP(bf16, WS_CQ), WSP(bf16, WS_KM) + (size_t)l * 8 * 65536};
            pg8::StaticOrder S; S.init(MROWS / 256, 4, G, bx); pg8::EpiScore E{WSP(bf16, WS_PT), WSP(float, WS_HSSQ), WSP(float, WS_PSUM)};
            for (int rep_ = 0; rep_ < REP_X; ++rep_) pg8::gemm_phase<pg8::GemmHeads, pg8::EpiScore, pg8::StaticOrder, true, true, false>(lds + RING_OFF, g, S, E, tid); }
        if (PHON(8) && IN(P + 8)) { KArgs ap = kargs(); unsigned char* ws = ap->ws; LTID; pg8::GemmHeads g{WSP(bf16, WS_PT), WSP(bf16, WS_VMT) + (size_t)l * 8 * 65536};
            pg8::StaticOrder S; S.init(MROWS / 256, 4, G, bx); pg8::EpiPV E{WSP(bf16, WS_CO), WSP(float, WS_PSUM)};
            for (int rep_ = 0; rep_ < REP_X; ++rep_) pg8::gemm_phase<pg8::GemmHeads, pg8::EpiPV, pg8::StaticOrder, true, true, false>(lds + RING_OFF, g, S, E, tid); }
        SEAM(P + 8);
        if (PHON(9) && IN(P + 9)) { KArgs ap = kargs(); unsigned char* ws = ap->ws; LTID; pg8::GemmK1024 g{WSP(bf16, WS_CO), (const bf16*)(ws + WS_W + (size_t)l * W_LAYER + W_CO)}; pg8::StaticOrder S; S.init(MROWS / 256, 4, G, bx);
            pg8::EpiRes E{nullptr, nullptr, WSP(bf16, WS_XB), WSP(float, WS_SSQ)}; pg8::gemm_phase<pg8::GemmK1024, pg8::EpiRes, pg8::StaticOrder, true, true, false>(lds + RING_OFF, g, S, E, tid); }
        SEAM(P + 9);
        if (PHON(10) && IN(P + 10)) { KArgs ap = kargs(); unsigned char* ws = ap->ws; LTID; pg8::GemmConv g{WSP(bf16, WS_XB) - DM, (const bf16*)(ws + WS_W + (size_t)l * W_LAYER + W_FI)};
            pg8::StaticOrder S; S.init(67, NFF / 256, G, bx); pg8::EpiFFN E{WSP(bf16, WS_ACT), WSP(float, WS_SSQ), ap->in[25] + (size_t)l * 3 * DFF, ap->in[26] + (size_t)l * DFF, MROWS};
            for (int rep_ = 0; rep_ < REP_FFI; ++rep_) pg8::gemm_phase<pg8::GemmConv, pg8::EpiFFN, pg8::StaticOrder, true, true, true>(lds + RING_OFF, g, S, E, tid); }
        SEAM(P + 10);
        if (PHON(11) && IN(P + 11)) { KArgs ap = kargs(); unsigned char* ws = ap->ws; LTID; pg8::GemmK2816 g{WSP(bf16, WS_ACT), (const bf16*)(ws + WS_W + (size_t)l * W_LAYER + W_FO)}; pg8::StaticOrder S; S.init(MROWS / 256, 4, G, bx);
            pg8::EpiRes E{nullptr, (l == DEPTH - 1) ? ap->out : (float*)nullptr, WSP(bf16, WS_XB), WSP(float, WS_SSQ)}; pg8::gemm_phase<pg8::GemmK2816, pg8::EpiRes, pg8::StaticOrder, true, true, false>(lds + RING_OFF, g, S, E, tid); }
        SEAM(P + 11);
    }
    if ((PROF_LO >= 0 || PROF_SUB >= 0) && bx == 0) { const unsigned long long t_end = __builtin_amdgcn_s_memrealtime() + 9ull * (tp1 - tp0); while (__builtin_amdgcn_s_memrealtime() < t_end) __builtin_amdgcn_s_sleep(8); }
#undef IN
#undef SEAM
}

#ifndef MK_CUTS
#define MK_CUTS 0
#endif
extern "C" void kernel_launch(void* const* d_in, const int* in_sizes, int n_in, void* d_out, int out_size, void* d_ws, size_t ws_size, hipStream_t stream) {
    static int grid = 0;
    if (grid == 0) {
        if (n_in != 28 || out_size != MROWS * DM || ws_size < WS_END) { fprintf(stderr, "kernel_launch: unexpected shapes (n_in %d, out %d, ws %zu)\n", n_in, out_size, ws_size); grid = -1; return; }
        int dev = 0, cus = 0, per_cu = 0;
        hipGetDevice(&dev); hipDeviceGetAttribute(&cus, hipDeviceAttributeMultiprocessorCount, dev);
        if (hipFuncSetAttribute((const void*)hybrid_fwd, hipFuncAttributeMaxDynamicSharedMemorySize, LDS_BYTES) != hipSuccess) { fprintf(stderr, "kernel_launch: hipFuncSetAttribute failed\n"); grid = -1; return; }
        if (hipOccupancyMaxActiveBlocksPerMultiprocessor(&per_cu, (const void*)hybrid_fwd, NTHR, LDS_BYTES) != hipSuccess || per_cu < 1) { fprintf(stderr, "kernel_launch: occupancy query says %d\n", per_cu); per_cu = 1; }
        (void)hipGetLastError();
        grid = cus;
    }
    if (grid < 0) return;
    Args a{};
    for (int i = 0; i < 28; ++i) a.in[i] = (const float*)d_in[i];
    a.out = (float*)d_out; a.ws = (unsigned char*)d_ws;
    constexpr int NPH = 1 + 12 * DEPTH;
#if MK_CUTS
    for (int p = 0; p < NPH; ++p) { a.ph_lo = p; a.ph_hi = p + 1; void* kargs[] = {&a};
        hipError_t e = hipLaunchCooperativeKernel((const void*)hybrid_fwd, dim3(grid), dim3(NTHR), kargs, LDS_BYTES, stream);
        if (e != hipSuccess) { fprintf(stderr, "launch %d failed: %s\n", p, hipGetErrorString(e)); break; } }
#else
    a.ph_lo = 0; a.ph_hi = NPH; void* kargs[] = {&a};
    hipError_t e = hipLaunchCooperativeKernel((const void*)hybrid_fwd, dim3(grid), dim3(NTHR), kargs, LDS_BYTES, stream);
    if (e != hipSuccess) fprintf(stderr, "cooperative launch failed: %s (grid %d)\n", hipGetErrorString(e), grid);
#endif
}
```

```cpp
#include <hip/hip_runtime.h>
#include <hip/hip_cooperative_groups.h>
#include <hip/hip_bf16.h>
#include <cstdio>
#include <cstdint>
#include <cmath>
namespace cg = cooperative_groups;
__device__ __forceinline__ float bperm(int srclane, float v) { return __int_as_float(__builtin_amdgcn_ds_bpermute(srclane << 2, __float_as_int(v))); }
#define SHX(v, m) bperm(lane ^ (m), (v))
#define SHU(v, o) bperm(lane - (o), (v))
#define SHD(v, o) bperm(lane + (o), (v))
#define SHI(v, src) bperm((src), (v))

namespace pg8 {
#define PG8_LAS __attribute__((address_space(3)))
typedef unsigned short bf16_t;
typedef short bf16x8 __attribute__((ext_vector_type(8)));
typedef float f32x4 __attribute__((ext_vector_type(4)));
typedef unsigned u32x4 __attribute__((ext_vector_type(4)));
typedef unsigned u32x2 __attribute__((ext_vector_type(2)));
constexpr int BM = 256, BK = 64, HALF = 128, HTB = HALF * BK * 2  , STAGE_BYTES = 8 * HTB, NXCD = 8, WGM = 8;

__host__ __device__ __forceinline__ int lds_byte(int r, int c) { const int st = (r >> 4) * 2 + (c >> 5), rr = r & 15, cc = c & 31, ob = rr * 64 + cc * 2; return st * 1024 + (ob ^ (((ob >> 9) & 1) << 5)); }
__host__ __device__ __forceinline__ void stage_rc(int b, int& R, int& C) { const int st = b / 1024, sb = b % 1024, swz = sb ^ (((sb >> 9) & 1) << 5); R = (st >> 1) * 16 + swz / 64; C = (st & 1) * 32 + (swz % 64) / 2; }
__host__ __device__ __forceinline__ int perm32(int rho) { const int n = rho >> 4, i = rho & 15; return 8 * (i >> 2) + 4 * n + (i & 3); }

struct Unit { int pm, pn; };
template <int LDA, int LDB, int KK, long AT, long AN, long BN, long BZ, int ZDIV> struct GemmT {
    const bf16_t* A; const bf16_t* Bt;
    static constexpr int lda = LDA, ldb = LDB, K = KK;
    __device__ __forceinline__ long offA(const Unit& u) const { return (long)u.pm * AT + (long)u.pn * AN; }
    __device__ __forceinline__ long offB(const Unit& u) const { return (long)u.pn * BN + (ZDIV > 0 ? (long)(u.pm / (ZDIV > 0 ? ZDIV : 1)) * BZ : 0L); }
};
typedef GemmT<1024, 1024, 1024, 256L * 1024 * 2, 0, 256L * 1024 * 2, 0, 0> GemmK1024;
typedef GemmT<2816, 2816, 2816, 256L * 2816 * 2, 0, 256L * 2816 * 2, 0, 0> GemmK2816;
typedef GemmT<1024, 1024, 1024, 248L * 1024 * 2, 0, 256L * 1024 * 2, 0, 0> GemmConv;
typedef GemmT<1024, 256, 256, 256L * 1024 * 2, 512, 65536L * 2, 4L * 65536 * 2, 32> GemmHeads;

struct StaticOrder {
    int nM, nN, nwg, G, c, pn0;
    __host__ __device__ void init(int nM_, int nN_, int G_, int c_, int pn0_ = 0) { nM = nM_; nN = nN_; nwg = nM * nN; G = G_; c = c_; pn0 = pn0_; }
    __host__ __device__ bool next(int i, Unit& u) const {
        const long L = (long)i * G + c; if (L >= nwg) return false;
        int wgid = (int)L; { const int q = nwg / NXCD, r = nwg % NXCD, xcd = wgid % NXCD, off = wgid / NXCD; wgid = (xcd < r ? xcd * (q + 1) : r * (q + 1) + (xcd - r) * q) + off; }
        const int nig = WGM * nN, gid = wgid / nig, fm = gid * WGM, gsz = (nM - fm) < WGM ? (nM - fm) : WGM;
        u.pm = fm + ((wgid % nig) % gsz); u.pn = pn0 + (wgid % nig) / gsz; return true;
    }
    __device__ __forceinline__ void a_ready(const Unit&) const {}
    __device__ __forceinline__ void done(const Unit&) const {}
};
__device__ __forceinline__ unsigned cvt_pk_bf16(float lo, float hi) { unsigned r; asm volatile("v_cvt_pk_bf16_f32 %0, %1, %2" : "=v"(r) : "v"(lo), "v"(hi)); return r; }


template <class GT, class Epi, class Sched, bool ALIGN_EPI = false, bool SP2 = false, bool CONV = false>
__device__ __forceinline__ void gemm_phase(PG8_LAS unsigned char* lds, const GT g, const Sched& S, const Epi& E, const int tid_in) {
    static_assert(SP2, "only the SP2 loop is kept valid here");
    int tid_l = tid_in; asm volatile("" : "+v"(tid_l));
    const int tid = tid_l, wid = __builtin_amdgcn_readfirstlane(tid >> 6), lane = tid & 63, wr = wid >> 2, wc = wid & 3, fr = lane & 15, fq = lane >> 4;
    constexpr int nt = GT::K / BK;
    unsigned voffA[2], voffB[2];
#pragma unroll
    for (int i = 0; i < 2; ++i) { int R, C; stage_rc(tid * 16 + i * 8192, R, C); const int Rb = Epi::PERM ? ((R & ~31) + perm32(R & 31)) : R;
        const int Ra = CONV ? (R - 2 * (R >> 6)) : R; voffA[i] = (unsigned)(Ra * GT::lda + C) * 2u; voffB[i] = (unsigned)(Rb * GT::ldb + C) * 2u; }
    const size_t kstep = (size_t)(BK * 2);
    constexpr size_t hA = (size_t)(CONV ? 124 : HALF) * GT::lda * 2, hB = (size_t)HALF * GT::ldb * 2;
    const unsigned ldsw = (unsigned)wid * 1024u;
    const int aoff = lds_byte(wr * 64 + fr, fq * 8), boff = lds_byte(wc * 32 + fr, fq * 8);
#define PG8_SA(b, h) (((b) * 2 + (h)) * HTB)
#define PG8_SB(b, h) ((4 + (b) * 2 + (h)) * HTB)
#define PG8_STAGE(bufoff, gbase, voff) do { _Pragma("unroll") for (int _i = 0; _i < 2; ++_i) \
        __builtin_amdgcn_global_load_lds((const unsigned*)((const char*)(gbase) + (voff)[_i]), (PG8_LAS unsigned*)(lds + (bufoff) + ldsw + _i * 8192), 16, 0, 0); } while (0)
#define PG8_LDA(dst, b, h) do { _Pragma("unroll") for (int m = 0; m < 4; ++m) _Pragma("unroll") for (int k = 0; k < 2; ++k) dst[m][k] = *(const PG8_LAS bf16x8*)(lds + PG8_SA(b, h) + aoff + m * 2048 + k * 1024); } while (0)
#define PG8_LDB(dst, b, h) do { _Pragma("unroll") for (int n = 0; n < 2; ++n) _Pragma("unroll") for (int k = 0; k < 2; ++k) dst[n][k] = *(const PG8_LAS bf16x8*)(lds + PG8_SB(b, h) + boff + n * 2048 + k * 1024); } while (0)
#define PG8_MMA(ai, bj, At, Bt) do { __builtin_amdgcn_s_setprio(1); _Pragma("unroll") for (int m = 0; m < 4; ++m) _Pragma("unroll") for (int n = 0; n < 2; ++n) _Pragma("unroll") for (int k = 0; k < 2; ++k) \
        acc[ai][bj][m][n] = __builtin_amdgcn_mfma_f32_16x16x32_bf16(Bt[n][k], At[m][k], acc[ai][bj][m][n], 0, 0, 0); __builtin_amdgcn_s_setprio(0); } while (0)
#define PG8_WAIT_V(n) asm volatile("s_waitcnt vmcnt(" #n ")" ::: "memory")
#define PG8_WAIT_L(n) asm volatile("s_waitcnt lgkmcnt(" #n ")" ::: "memory")
#define PG8_BAR __builtin_amdgcn_s_barrier()
#define PG8_SCHED __builtin_amdgcn_sched_barrier(0)
    Unit cur, nxt; int ui = 0;
    if (!S.next(0, cur)) return;
    f32x4 acc[2][2][4][2];
#pragma unroll
    for (int a = 0; a < 2; ++a)
#pragma unroll
        for (int b = 0; b < 2; ++b)
#pragma unroll
            for (int m = 0; m < 4; ++m)
#pragma unroll
                for (int n = 0; n < 2; ++n) acc[a][b][m][n] = (f32x4){0.f, 0.f, 0.f, 0.f};
    bf16x8 At[4][2], B0[2][2], B1[2][2];
    const char* cA = (const char*)g.A + g.offA(cur); const char* cB = (const char*)g.Bt + g.offB(cur);
    S.a_ready(cur);
    if constexpr (SP2) {
        PG8_STAGE(PG8_SB(0, 0), cB, voffB); PG8_STAGE(PG8_SB(0, 1), cB + hB, voffB); PG8_STAGE(PG8_SA(0, 0), cA, voffA); PG8_STAGE(PG8_SA(0, 1), cA + hA, voffA);
        if (wr == 1) PG8_BAR;
        PG8_WAIT_V(2); PG8_BAR;
        PG8_STAGE(PG8_SB(1, 0), cB + kstep, voffB); PG8_STAGE(PG8_SA(1, 0), cA + kstep, voffA); PG8_STAGE(PG8_SB(1, 1), cB + hB + kstep, voffB);
        PG8_WAIT_V(6); PG8_BAR;
    } else {
        PG8_STAGE(PG8_SB(0, 0), cB, voffB); PG8_STAGE(PG8_SA(0, 0), cA, voffA); PG8_STAGE(PG8_SB(0, 1), cB + hB, voffB); PG8_STAGE(PG8_SA(0, 1), cA + hA, voffA);
        if (wr == 1) PG8_BAR;
        PG8_WAIT_V(4); PG8_BAR;
        PG8_STAGE(PG8_SB(1, 0), cB + kstep, voffB); PG8_STAGE(PG8_SA(1, 0), cA + kstep, voffA); PG8_STAGE(PG8_SB(1, 1), cB + hB + kstep, voffB);
        PG8_WAIT_V(6); PG8_BAR;
    }
    for (;;) {
        const bool has_next = S.next(ui + 1, nxt);
        const char* nA = has_next ? (const char*)g.A + g.offA(nxt) : cA; const char* nB = has_next ? (const char*)g.Bt + g.offB(nxt) : cB;
        for (int t = 0; t < nt; t += 2) {
            const bool last = (t == nt - 2);
            const char* a1 = cA + (size_t)(t + 1) * kstep;
            const char* a2 = last ? nA : cA + (size_t)(t + 2) * kstep; const char* b2 = last ? nB : cB + (size_t)(t + 2) * kstep;
            const char* a3 = a2 + kstep; const char* b3 = b2 + kstep;
            if (last && has_next) S.a_ready(nxt);
            if constexpr (SP2) {
            PG8_LDB(B0, 0, 0); PG8_LDB(B1, 0, 1); PG8_SCHED; PG8_LDA(At, 0, 0); PG8_STAGE(PG8_SA(1, 1), a1 + hA, voffA);
            PG8_WAIT_V(8); PG8_WAIT_L(0); PG8_BAR; PG8_MMA(0, 0, At, B0); PG8_MMA(0, 1, At, B1); PG8_BAR; PG8_SCHED;
            PG8_LDA(At, 0, 1); PG8_STAGE(PG8_SB(0, 0), b2, voffB); PG8_STAGE(PG8_SB(0, 1), b2 + hB, voffB); PG8_STAGE(PG8_SA(0, 0), a2, voffA);
            PG8_WAIT_V(8); PG8_WAIT_L(0); PG8_BAR; PG8_MMA(1, 0, At, B0); PG8_MMA(1, 1, At, B1); PG8_BAR; PG8_SCHED;
            PG8_LDB(B0, 1, 0); PG8_LDB(B1, 1, 1); PG8_SCHED; PG8_LDA(At, 1, 0); PG8_STAGE(PG8_SA(0, 1), a2 + hA, voffA);
            PG8_WAIT_V(8); PG8_WAIT_L(0); PG8_BAR; PG8_MMA(0, 0, At, B0); PG8_MMA(0, 1, At, B1); PG8_BAR; PG8_SCHED;
            PG8_LDA(At, 1, 1); PG8_STAGE(PG8_SB(1, 0), b3, voffB); PG8_STAGE(PG8_SB(1, 1), b3 + hB, voffB); PG8_STAGE(PG8_SA(1, 0), a3, voffA);
            PG8_WAIT_V(8); PG8_WAIT_L(0); PG8_BAR; PG8_MMA(1, 0, At, B0); PG8_MMA(1, 1, At, B1); PG8_BAR; PG8_SCHED;
            } else {
            PG8_LDB(B0, 0, 0); PG8_SCHED; PG8_LDA(At, 0, 0); PG8_STAGE(PG8_SA(1, 1), a1 + hA, voffA);
            PG8_WAIT_L(8); PG8_BAR; PG8_WAIT_L(0); PG8_MMA(0, 0, At, B0); PG8_BAR; PG8_SCHED;
            PG8_LDB(B1, 0, 1); PG8_STAGE(PG8_SB(0, 0), b2, voffB);
            PG8_BAR; PG8_WAIT_L(0); PG8_MMA(0, 1, At, B1); PG8_BAR;
            PG8_LDA(At, 0, 1); PG8_STAGE(PG8_SA(0, 0), a2, voffA);
            PG8_BAR; PG8_WAIT_L(0); PG8_MMA(1, 0, At, B0); PG8_BAR; PG8_SCHED;
            PG8_STAGE(PG8_SB(0, 1), b2 + hB, voffB);
            PG8_WAIT_V(6); PG8_BAR; PG8_MMA(1, 1, At, B1); PG8_BAR;
            PG8_LDB(B0, 1, 0); PG8_SCHED; PG8_LDA(At, 1, 0); PG8_STAGE(PG8_SA(0, 1), a2 + hA, voffA);
            PG8_WAIT_L(8); PG8_BAR; PG8_WAIT_L(0); PG8_MMA(0, 0, At, B0); PG8_BAR; PG8_SCHED;
            PG8_LDB(B1, 1, 1); PG8_STAGE(PG8_SB(1, 0), b3, voffB);
            PG8_BAR; PG8_WAIT_L(0); PG8_MMA(0, 1, At, B1); PG8_BAR;
            PG8_LDA(At, 1, 1); PG8_STAGE(PG8_SA(1, 0), a3, voffA);
            PG8_BAR; PG8_WAIT_L(0); PG8_MMA(1, 0, At, B0); PG8_BAR; PG8_SCHED;
            PG8_STAGE(PG8_SB(1, 1), b3 + hB, voffB);
            PG8_WAIT_V(6); PG8_BAR; PG8_MMA(1, 1, At, B1); PG8_BAR;
            }
        }
        if constexpr (ALIGN_EPI) { if (wr == 0) PG8_BAR; }
        if constexpr (!Epi::AFTER_DRAIN) { { int l_e; asm volatile("v_mbcnt_lo_u32_b32 %0, -1, 0\n\tv_mbcnt_hi_u32_b32 %0, -1, %0" : "=v"(l_e)); E(acc, cur, wr, wc, l_e & 15, l_e >> 4); } S.done(cur); }
        if (!has_next) break;
#pragma unroll
        for (int a = 0; a < 2; ++a)
#pragma unroll
            for (int b = 0; b < 2; ++b)
#pragma unroll
                for (int m = 0; m < 4; ++m)
#pragma unroll
                    for (int n = 0; n < 2; ++n) acc[a][b][m][n] = (f32x4){0.f, 0.f, 0.f, 0.f};
        cur = nxt; cA = nA; cB = nB; ++ui;
        if constexpr (ALIGN_EPI) { if (wr == 1) PG8_BAR; }
    }
    PG8_WAIT_V(0);
    if constexpr (!ALIGN_EPI) { if (wr == 0) PG8_BAR; }
    PG8_BAR;
    if constexpr (Epi::AFTER_DRAIN) { E.fused(acc, cur, wr, wc, fr, fq, lds, wid, lane); S.done(cur); }
#undef PG8_SA
#undef PG8_SB
#undef PG8_STAGE
#undef PG8_LDA
#undef PG8_LDB
#undef PG8_MMA
#undef PG8_WAIT_V
#undef PG8_WAIT_L
#undef PG8_BAR
#undef PG8_SCHED
}

template <int CTRL> __device__ __forceinline__ float dpp_ror(float v) { return __int_as_float(__builtin_amdgcn_update_dpp(0, __float_as_int(v), CTRL, 0xf, 0xf, false)); }
template <int CTRL> __device__ __forceinline__ float dpp_shift(float old, float v) { return __int_as_float(__builtin_amdgcn_update_dpp(__float_as_int(old), __float_as_int(v), CTRL, 0xf, 0xf, false)); }
typedef f32x4 Acc[2][2][4][2];
__device__ __forceinline__ float sum16(const float* p) {
    const f32x4 a = *(const f32x4*)p, b = *(const f32x4*)(p + 4), c = *(const f32x4*)(p + 8), d = *(const f32x4*)(p + 12);
    return ((a[0] + a[1]) + (a[2] + a[3])) + ((b[0] + b[1]) + (b[2] + b[3])) + ((c[0] + c[1]) + (c[2] + c[3])) + ((d[0] + d[1]) + (d[2] + d[3]));
}
__device__ __forceinline__ float sum16q(const float* p, int fq, int lane) {
    const f32x4 a = *(const f32x4*)(p + 4 * fq); float s = (a[0] + a[1]) + (a[2] + a[3]); s += SHX(s, 16); s += SHX(s, 32); return s;
}
__device__ __forceinline__ float dot4(const f32x4 v) { return (v[0] * v[0] + v[1] * v[1]) + (v[2] * v[2] + v[3] * v[3]); }
__device__ __forceinline__ u32x4 pack8(const f32x4 a, const f32x4 b) { u32x4 w; w.x = cvt_pk_bf16(a[0], a[1]); w.y = cvt_pk_bf16(a[2], a[3]); w.z = cvt_pk_bf16(b[0], b[1]); w.w = cvt_pk_bf16(b[2], b[3]); return w; }

struct EpiScaled {
    static constexpr bool PERM = true, AFTER_DRAIN = false;
    bf16_t* O; int ldc; const float* ssq; float* HS;
    __device__ __forceinline__ void operator()(Acc& acc, const Unit& u, int wr, int wc, int fr, int fq) const {
        const int lane = fq * 16 + fr; (void)lane; const int row0 = u.pm * BM + wr * 64 + fr, col0 = u.pn * BM + wc * 32 + 8 * fq;
        float rsv[2][4];
#pragma unroll
        for (int ai = 0; ai < 2; ++ai)
#pragma unroll
            for (int m = 0; m < 4; ++m) rsv[ai][m] = __builtin_amdgcn_rsqf(sum16q(ssq + (size_t)(row0 + ai * HALF + m * 16) * 16, fq, lane) * (1.0f / 1024.0f) + 1e-6f);
#pragma unroll
        for (int ai = 0; ai < 2; ++ai)
#pragma unroll
            for (int m = 0; m < 4; ++m) { const int r = row0 + ai * HALF + m * 16; const float rs = rsv[ai][m];
                bf16_t* rowp = O + (size_t)r * ldc + col0; float ss = 0.f;
#pragma unroll
                for (int bj = 0; bj < 2; ++bj) { const f32x4 v0 = acc[ai][bj][m][0] * rs, v1 = acc[ai][bj][m][1] * rs; ss += dot4(v0) + dot4(v1); *(u32x4*)(rowp + bj * HALF) = pack8(v0, v1); }
                if (HS) { ss += SHX(ss, 16); ss += SHX(ss, 32); if (fq == 0) HS[(size_t)r * 16 + u.pn * 4 + wc] = ss; } }
    }
};
struct EpiRes {
    static constexpr bool PERM = true, AFTER_DRAIN = false;
    const float* base32; float* out32; bf16_t* xb; float* ssq;
    __device__ __forceinline__ void operator()(Acc& acc, const Unit& u, int wr, int wc, int fr, int fq) const {
        const int lane = fq * 16 + fr; (void)lane; const int row0 = u.pm * BM + wr * 64 + fr, col0 = u.pn * BM + wc * 32 + 8 * fq;
#pragma unroll
        for (int ai = 0; ai < 2; ++ai)
#pragma unroll
            for (int m = 0; m < 4; ++m) { if ((m & 1) == 0) asm volatile("" ::: "memory"); const int r = row0 + ai * HALF + m * 16; const size_t off = (size_t)r * 1024 + col0; float ss = 0.f;
#pragma unroll
                for (int bj = 0; bj < 2; ++bj) { const size_t o_ = off + bj * HALF; f32x4 o0, o1;
                    if (base32) { o0 = *(const f32x4*)(base32 + o_); o1 = *(const f32x4*)(base32 + o_ + 4); }
                    else { const u32x4 b = *(const u32x4*)(xb + o_);
                        o0 = (f32x4){__uint_as_float(b.x << 16), __uint_as_float(b.x & 0xffff0000u), __uint_as_float(b.y << 16), __uint_as_float(b.y & 0xffff0000u)};
                        o1 = (f32x4){__uint_as_float(b.z << 16), __uint_as_float(b.z & 0xffff0000u), __uint_as_float(b.w << 16), __uint_as_float(b.w & 0xffff0000u)}; }
                    o0 = o0 + acc[ai][bj][m][0]; o1 = o1 + acc[ai][bj][m][1]; ss += dot4(o0) + dot4(o1);
                    if (out32) { *(f32x4*)(out32 + o_) = o0; *(f32x4*)(out32 + o_ + 4) = o1; }
                    *(u32x4*)(xb + o_) = pack8(o0, o1); }
                ss += SHX(ss, 16); ss += SHX(ss, 32); if (fq == 0) ssq[(size_t)r * 16 + u.pn * 4 + wc] = ss; }
    }
};
struct EpiF32 {
    static constexpr bool PERM = false, AFTER_DRAIN = false;
    float* out; int ldc;
    __device__ __forceinline__ void operator()(Acc& acc, const Unit& u, int wr, int wc, int fr, int fq) const {
        const int lane = fq * 16 + fr; (void)lane; const int row0 = u.pm * BM + wr * 64 + fr, col0 = u.pn * BM + wc * 32 + 4 * fq;
#pragma unroll
        for (int ai = 0; ai < 2; ++ai)
#pragma unroll
            for (int m = 0; m < 4; ++m) { const size_t off = (size_t)(row0 + ai * HALF + m * 16) * ldc + col0;
#pragma unroll
                for (int bj = 0; bj < 2; ++bj)
#pragma unroll
                    for (int n = 0; n < 2; ++n) *(f32x4*)(out + off + bj * HALF + n * 16) = acc[ai][bj][m][n]; }
    }
};
struct EpiScore {
    static constexpr bool PERM = true, AFTER_DRAIN = false;
    bf16_t* PT; const float* HS; float* PS;
    __device__ __forceinline__ void operator()(Acc& acc, const Unit& u, int wr, int wc, int fr, int fq) const {
        const int lane = fq * 16 + fr; (void)lane; const int row0 = u.pm * BM + wr * 64 + fr, col0 = u.pn * BM + wc * 32 + 8 * fq;
#pragma unroll
        for (int ai = 0; ai < 2; ++ai)
#pragma unroll
            for (int m = 0; m < 4; ++m) { const int r = row0 + ai * HALF + m * 16; const f32x4 h4 = *(const f32x4*)(HS + (size_t)r * 16 + u.pn * 4);
                const float rq = __builtin_amdgcn_rsqf(((h4[0] + h4[1]) + (h4[2] + h4[3])) * (1.0f / 256.0f) + 1e-6f); bf16_t* rowp = PT + (size_t)r * 1024 + col0; float ss = 0.f;
#pragma unroll
                for (int bj = 0; bj < 2; ++bj) { f32x4 v0 = acc[ai][bj][m][0] * rq, v1 = acc[ai][bj][m][1] * rq;
#pragma unroll
                    for (int j = 0; j < 4; ++j) { v0[j] = __builtin_amdgcn_exp2f(v0[j]); v1[j] = __builtin_amdgcn_exp2f(v1[j]); }
                    ss += ((v0[0] + v0[1]) + (v0[2] + v0[3])) + ((v1[0] + v1[1]) + (v1[2] + v1[3])); *(u32x4*)(rowp + bj * HALF) = pack8(v0, v1); }
                ss += SHX(ss, 16); ss += SHX(ss, 32); if (fq == 0) PS[(size_t)r * 16 + u.pn * 4 + wc] = ss; }
    }
};
struct EpiPV {
    static constexpr bool PERM = true, AFTER_DRAIN = false;
    bf16_t* O; const float* PS;
    __device__ __forceinline__ void operator()(Acc& acc, const Unit& u, int wr, int wc, int fr, int fq) const {
        const int lane = fq * 16 + fr; (void)lane; const int row0 = u.pm * BM + wr * 64 + fr, col0 = u.pn * BM + wc * 32 + 8 * fq;
#pragma unroll
        for (int ai = 0; ai < 2; ++ai)
#pragma unroll
            for (int m = 0; m < 4; ++m) { const int r = row0 + ai * HALF + m * 16; const f32x4 p4 = *(const f32x4*)(PS + (size_t)r * 16 + u.pn * 4);
                const float inv = 1.0f / ((p4[0] + p4[1]) + (p4[2] + p4[3])); bf16_t* rowp = O + (size_t)r * 1024 + col0;
#pragma unroll
                for (int bj = 0; bj < 2; ++bj) *(u32x4*)(rowp + bj * HALF) = pack8(acc[ai][bj][m][0] * inv, acc[ai][bj][m][1] * inv); }
    }
};
struct EpiFFN {
    static constexpr bool PERM = true, AFTER_DRAIN = false;
    bf16_t* act; const float* ssq; const float* cw; const float* cb; int Mrows;
    __device__ __forceinline__ void operator()(Acc& acc, const Unit& u, int wr, int wc, int fr, int fq) const {
        const int lane = fq * 16 + fr; const int jc = u.pn * 128 + wc * 32 + 8 * fq;
        float rsv[2][4];
#pragma unroll
        for (int ai = 0; ai < 2; ++ai)
#pragma unroll
            for (int m = 0; m < 4; ++m) { const int gr = 62 * (4 * u.pm + 2 * ai + wr) - 1 + 16 * m + fr; const bool valid = gr >= 0 && gr < Mrows; const int grc = valid ? gr : 0;
                const float rs = __builtin_amdgcn_rsqf(sum16q(ssq + (size_t)grc * 16, fq, lane) * (1.0f / 1024.0f) + 1e-6f); rsv[ai][m] = valid ? rs : 0.f; }
#pragma unroll
        for (int ai = 0; ai < 2; ++ai)
#pragma unroll
            for (int m = 0; m < 4; ++m)
#pragma unroll
                for (int bj = 0; bj < 2; ++bj)
#pragma unroll
                    for (int n = 0; n < 2; ++n)
#pragma unroll
                        for (int j = 0; j < 4; ++j) { const float v = acc[ai][bj][m][n][j] * rsv[ai][m]; acc[ai][bj][m][n][j] = (rsv[ai][m] == 0.f) ? 0.f : v; }
#pragma unroll
        for (int n = 0; n < 2; ++n) {
            asm volatile("" ::: "memory");
            const f32x4 w0 = *(const f32x4*)(cw + jc + 4 * n), w1 = *(const f32x4*)(cw + 2816 + jc + 4 * n), w2 = *(const f32x4*)(cw + 5632 + jc + 4 * n), bb = *(const f32x4*)(cb + jc + 4 * n);
#pragma unroll
            for (int ai = 0; ai < 2; ++ai) {
                const int g0 = 62 * (4 * u.pm + 2 * ai + wr) - 1;
#pragma unroll
                for (int m = 0; m < 4; ++m) { const int rr = 16 * m + fr, gr = g0 + rr, t = gr & 8191; f32x4 o;
#pragma unroll
                    for (int j = 0; j < 4; ++j) { const float cur = acc[ai][0][m][n][j];
                        const float up_wrap = (m > 0) ? dpp_ror<0x121>(acc[ai][0][m > 0 ? m - 1 : 0][n][j]) : 0.f;
                        const float dn_wrap = (m < 3) ? dpp_ror<0x12F>(acc[ai][0][m < 3 ? m + 1 : 3][n][j]) : 0.f;
                        float prev = dpp_shift<0x111>(up_wrap, cur), next = dpp_shift<0x101>(dn_wrap, cur);
                        prev = (t == 0) ? 0.f : prev; next = (t == 8191) ? 0.f : next;
                        const float gc = w0[j] * prev + w1[j] * cur + w2[j] * next + bb[j];
                        o[j] = gc * __builtin_amdgcn_rcpf(1.0f + __expf(-gc)) * acc[ai][1][m][n][j]; }
                    if (rr >= 1 && rr <= 62 && gr < Mrows) { u32x2 w; w.x = cvt_pk_bf16(o[0], o[1]); w.y = cvt_pk_bf16(o[2], o[3]); *(u32x2*)(act + (size_t)gr * 2816 + jc + 4 * n) = w; }
                    __builtin_amdgcn_sched_barrier(0); }
            }
        }
    }
};
}

namespace attn_body {
using bf16=__hip_bfloat16;
using bf16x8=__attribute__((ext_vector_type(8)))short;
using s16x4=__attribute__((ext_vector_type(4)))short;
using f32x16=__attribute__((ext_vector_type(16)))float;
using u32x4=__attribute__((ext_vector_type(4)))unsigned;
constexpr int SEQ=8192,D=64,ldk=2560,ldv=2560;
constexpr int NW=8,QBLK=32,QB=QBLK*NW,KVBLK=64,NQB=SEQ/QB;
constexpr int ATTN_UNIT_ROWS=QB;
__device__ __forceinline__ int crow(int r,int hi){return (r&3)+8*(r>>2)+4*hi;}
#define SBAR() __builtin_amdgcn_sched_barrier(0)
__device__ __forceinline__ void cmask(f32x16&p0,f32x16&p1,int jb,int qrel,int hi){
  const float NEG=-INFINITY; int kb=64*jb+4*hi;
  #pragma unroll
  for(int r=0;r<16;++r){int kv=kb+(r&3)+8*(r>>2); if(kv>qrel)p0[r]=NEG; if(kv+32>qrel)p1[r]=NEG;}
}

constexpr int NSLOT=3, SLOTB=8192;
constexpr int LDS_K=0, LDS_V=NSLOT*SLOTB, LDS_WS=2*NSLOT*SLOTB, LDS_OST=LDS_WS+NW*64*4, LDS_BYTES=LDS_OST+NW*4096;
constexpr float C2=0.125f*1.4426950408889634f;
__device__ __forceinline__ void glds16(const void*gsrc,unsigned lds_dst){unsigned keep;
  asm volatile("s_mov_b32 %0, m0\n\ts_mov_b32 m0, %2\n\ts_nop 0\n\tglobal_load_lds_dwordx4 %1, off\n\ts_mov_b32 m0, %0":"=&s"(keep):"v"(gsrc),"s"(lds_dst):"memory");}
__device__ __forceinline__ float max3f(float a,float b,float c){float r;asm("v_max3_f32 %0, %1, %2, %3":"=v"(r):"v"(a),"v"(b),"v"(c));return r;}
__device__ __forceinline__ float max2f(float a,float b){float r;asm("v_max_f32_e32 %0, %1, %2":"=v"(r):"v"(a),"v"(b));return r;}
__device__ __forceinline__ float fadd_s(float a,float b){float r;asm("v_add_f32_e32 %0, %1, %2":"=v"(r):"v"(a),"v"(b));return r;}
__device__ __forceinline__ float fsub_s(float a,float b){float r;asm("v_sub_f32_e32 %0, %1, %2":"=v"(r):"v"(a),"v"(b));return r;}
typedef float f32x2_t __attribute__((ext_vector_type(2))); typedef __bf16 bf16x2_t __attribute__((ext_vector_type(2)));
__device__ __forceinline__ unsigned cvtpk_s(float lo,float hi){f32x2_t v={lo,hi};bf16x2_t b=__builtin_convertvector(v,bf16x2_t);return __builtin_bit_cast(unsigned,b);}
#define WAIT_BAR(N) asm volatile("s_waitcnt vmcnt(" #N ") lgkmcnt(0)\n\ts_barrier":::"memory")

template<int MODE> __device__ __forceinline__ void qkt(f32x16&p0,f32x16&p1,const char*Kslot,const bf16x8*qr,const f32x16&negm,int r32,int hi){
  const char*kb=Kslot+hi*1024+r32*16;
  #pragma unroll
  for(int d0=(MODE==2?2:0);d0<(MODE==1?2:4);++d0){
    const bf16x8 b0=*reinterpret_cast<const bf16x8*>(kb+d0*2048);
    const bf16x8 b1=*reinterpret_cast<const bf16x8*>(kb+d0*2048+512);
    if(d0==(MODE==2?2:0)){p0=__builtin_amdgcn_mfma_f32_32x32x16_bf16(b0,qr[d0],negm,0,0,0);p1=__builtin_amdgcn_mfma_f32_32x32x16_bf16(b1,qr[d0],negm,0,0,0);}
    else{p0=__builtin_amdgcn_mfma_f32_32x32x16_bf16(b0,qr[d0],p0,0,0,0);p1=__builtin_amdgcn_mfma_f32_32x32x16_bf16(b1,qr[d0],p1,0,0,0);}}
}
typedef __attribute__((address_space(3))) const char* lds_cptr;
typedef short v4i16_t __attribute__((ext_vector_type(4)));
__device__ __forceinline__ void kload8(bf16x8*kf,lds_cptr kp){
  kf[0]=*(const __attribute__((address_space(3))) bf16x8*)(kp);      kf[1]=*(const __attribute__((address_space(3))) bf16x8*)(kp+512);
  kf[2]=*(const __attribute__((address_space(3))) bf16x8*)(kp+2048); kf[3]=*(const __attribute__((address_space(3))) bf16x8*)(kp+2560);
  kf[4]=*(const __attribute__((address_space(3))) bf16x8*)(kp+4096); kf[5]=*(const __attribute__((address_space(3))) bf16x8*)(kp+4608);
  kf[6]=*(const __attribute__((address_space(3))) bf16x8*)(kp+6144); kf[7]=*(const __attribute__((address_space(3))) bf16x8*)(kp+6656);
}
__device__ __forceinline__ void kload2(bf16x8*kf,lds_cptr kp,int j){ kf[2*j]=*(const __attribute__((address_space(3))) bf16x8*)(kp+j*2048); kf[2*j+1]=*(const __attribute__((address_space(3))) bf16x8*)(kp+j*2048+512); }
__device__ __forceinline__ s16x4 vtr(lds_cptr p){ return __builtin_bit_cast(s16x4,__builtin_amdgcn_ds_read_tr16_b64_v4i16((__attribute__((address_space(3))) v4i16_t*)p)); }
__device__ __forceinline__ float rowmax(const f32x16&p0,const f32x16&p1){
  float a=max3f(p0[0],p0[1],p1[0]),b=max3f(p0[2],p0[3],p1[1]);a=max3f(a,p1[2],p1[3]);
  #pragma unroll
  for(int r=4;r<16;r+=4){a=max3f(a,p0[r],p0[r+1]);b=max3f(b,p0[r+2],p0[r+3]);a=max3f(a,p1[r],p1[r+1]);b=max3f(b,p1[r+2],p1[r+3]);}
  const float m=max2f(a,b);
  auto rr=__builtin_amdgcn_permlane32_swap(__float_as_uint(m),__float_as_uint(m),false,false);
  return max2f(__uint_as_float(rr[0]),__uint_as_float(rr[1]));
}
__device__ __forceinline__ void pv(f32x16*o,int vb,bf16x8 pa0,bf16x8 pa1,bf16x8 pa2,bf16x8 pa3){
  #pragma unroll
  for(int d0=0;d0<2;++d0){s16x4 lo[4],hi[4];
    #pragma unroll
    for(int ks=0;ks<4;++ks){
      asm volatile("ds_read_b64_tr_b16 %0,%1 offset:%c2":"=&v"(lo[ks]):"v"(vb),"i"(d0*4096+ks*1024):"memory");
      asm volatile("ds_read_b64_tr_b16 %0,%1 offset:%c2":"=&v"(hi[ks]):"v"(vb),"i"(d0*4096+ks*1024+512):"memory");}
    asm volatile("s_waitcnt lgkmcnt(0)":::"memory");SBAR();
    #define PK(k) (bf16x8){lo[k][0],lo[k][1],lo[k][2],lo[k][3],hi[k][0],hi[k][1],hi[k][2],hi[k][3]}
    o[d0]=__builtin_amdgcn_mfma_f32_32x32x16_bf16(pa0,PK(0),o[d0],0,0,0);
    o[d0]=__builtin_amdgcn_mfma_f32_32x32x16_bf16(pa1,PK(1),o[d0],0,0,0);
    o[d0]=__builtin_amdgcn_mfma_f32_32x32x16_bf16(pa2,PK(2),o[d0],0,0,0);
    o[d0]=__builtin_amdgcn_mfma_f32_32x32x16_bf16(pa3,PK(3),o[d0],0,0,0);
    #undef PK
  }
}

#ifndef ATTN_STORE16
#define ATTN_STORE16(p,v) (*(u32x4*)(p)=(v))
#endif
template<int THRL,int MODE> __device__ __forceinline__ void attn_unit(const bf16*Qb,int ldq,const bf16*Kh,const bf16*Vh,bf16*Ob,int ldo,char*shm,const int tid_in,const float lam,const float post,const float*gsub){
  int tid_l=tid_in; asm volatile("":"+v"(tid_l));
  const int tid=tid_l,lane=tid&63,r32=lane&31,hi=lane>>5; const int wid=__builtin_amdgcn_readfirstlane(tid>>6);
  const bf16*Qw=Qb+(long)(wid*QBLK)*ldq;
  const unsigned lds0=(unsigned)(uintptr_t)shm;
  float*wsf=(float*)(shm+LDS_WS)+wid*64;
  const bf16*ksrc=Kh+(long)lane*ldk+wid*8;
  const bf16*vsrc=Vh+(long)(16*(wid&3)+(lane>>2))*ldv+(wid>>2)*32+(lane&3)*8;
  const unsigned kdst=lds0+LDS_K+wid*1024, vdst=lds0+LDS_V+wid*1024;
  #define DMA_K(t,slot) glds16(ksrc+(long)(t)*KVBLK*ldk,(unsigned)__builtin_amdgcn_readfirstlane(kdst+(slot)))
  #define DMA_V(t,slot) glds16(vsrc+(long)(t)*KVBLK*ldv,(unsigned)__builtin_amdgcn_readfirstlane(vdst+(slot)))
  const int vb0=(int)(lds0+LDS_V)+((lane>>4)&1)*32+(lane&3)*8+(4*hi+((lane&15)>>2))*64;
  const char*Kbase=shm+LDS_K; bf16x8 kf[8];
  const lds_cptr shm3=(lds_cptr)shm; const lds_cptr kp0=shm3+LDS_K+hi*1024+r32*16; const lds_cptr vp0=shm3+LDS_V+((lane>>4)&1)*32+(lane&3)*8+(4*hi+((lane&15)>>2))*64;
  constexpr int NT=SEQ/KVBLK;
  DMA_K(0,0);DMA_V(0,0);DMA_K(1,SLOTB);
  bf16x8 qr[4];
  #pragma unroll
  for(int d0=0;d0<4;++d0)qr[d0]=*reinterpret_cast<const bf16x8*>(&Qw[(long)r32*ldq+d0*16+hi*8]);
  float mhat=0.f,l_reg=0.f;f32x16 o[2];o[0]=f32x16{};o[1]=f32x16{};f32x16 negm=f32x16{};asm volatile("":"+v"(negm));
  #define CMASK(P0,P1,t) do{}while(0)
  bool resc=false;
  #define START(P0,P1) do{ const float rm=rowmax(P0,P1); resc=false; \
    { const float dl=rm; mhat=fadd_s(mhat,dl); \
      _Pragma("unroll") for(int r=0;r<16;++r){P0[r]=fsub_s(P0[r],dl);P1[r]=fsub_s(P1[r],dl);} \
      _Pragma("unroll") for(int r=0;r<16;++r)negm[r]=-mhat; asm volatile("":"+v"(negm)); } \
    _Pragma("unroll") for(int r=0;r<16;++r)P0[r]=__builtin_amdgcn_exp2f(P0[r]); }while(0)
  #define RESC() do{ if(resc){ asm volatile("s_waitcnt lgkmcnt(0)":::"memory"); \
      _Pragma("unroll") for(int d_=0;d_<2;++d_) _Pragma("unroll") for(int r=0;r<16;++r)o[d_][r]*=wsf[crow(r,hi)]; } }while(0)
  f32x16 pA0,pA1,pB0,pB1;
  int sl_prev=0,sl_cur=0,sl_next=SLOTB;
  #define ROT() do{sl_prev=sl_cur;sl_cur=sl_next;sl_next=(sl_next==(NSLOT-1)*SLOTB)?0:sl_next+SLOTB;}while(0)
  DMA_K(2,2*SLOTB);
  WAIT_BAR(3);
  qkt<MODE>(pA0,pA1,Kbase,qr,negm,r32,hi);asm volatile("s_nop 15\n\ts_nop 7":"+v"(pA0),"+v"(pA1));CMASK(pA0,pA1,0);
  START(pA0,pA1);
  _Pragma("unroll") for(int r=0;r<16;++r)pA1[r]=__builtin_amdgcn_exp2f(pA1[r]);
  WAIT_BAR(0);
  DMA_K(3,0);DMA_V(1,SLOTB);
  ROT();
  kload8(kf,kp0+sl_cur);
  WAIT_BAR(2);
  s16x4 vlo[8],vhi[8]; u32x4 pw0,pw1,pw2,pw3;
  #define PKW(P,B) cvtpk_s(P[B],P[B+1])
  #define PAF(k) __builtin_bit_cast(bf16x8,pw##k)
  #define VFR(i) (bf16x8){vlo[i][0],vlo[i][1],vlo[i][2],vlo[i][3],vhi[i][0],vhi[i][1],vhi[i][2],vhi[i][3]}
  #define PIN(x) asm volatile("":"+v"(x))
  #define MX3(a,b,c) __builtin_fmaxf(__builtin_fmaxf((a),(b)),(c))
  #define QKM(C,a,b,X) do{ if(MODE==0||(MODE==1&&(b)<2)||(MODE==2&&(b)>=2)){ C=__builtin_amdgcn_mfma_f32_32x32x16_bf16(kf[a],qr[b],((MODE==2&&(b)==2)?negm:(X)),0,0,0); } }while(0)
  #define GAPA(MF,A0,A1,A2,A3,W0,W1,PW) do{ MF; sacc+=A0; sacc+=A1; sacc+=A2; sacc+=A3; PIN(sacc); W0; W1; PIN(PW); SBAR(); }while(0)
  #define EX(v) __builtin_amdgcn_exp2f(v)
  #define GAPB(MF,X,B) do{ MF; X[B]=EX(X[B]); X[B+1]=EX(X[B+1]); X[B+2]=EX(X[B+2]); X[B+3]=EX(X[B+3]); PIN(X); SBAR(); }while(0)
  #define VRD(i) do{ vlo[i]=vtr(vp_+(((i)>>2)*4096+((i)&3)*1024)); vhi[i]=vtr(vp_+(((i)>>2)*4096+((i)&3)*1024+512)); }while(0)
  #define KRD(G,j) do{ if(G){ kload2(kf,kp0+sl_next,j); SBAR(); } }while(0)
  #define STEP(C0,C1,P0,P1,t,GK,GV,GL) do{ SBAR(); \
    const lds_cptr vp_=vp0+sl_prev; \
    VRD(0); SBAR(); float sacc=(P0[0]+P0[1]); \
    GAPA(QKM(C0,0,0,negm), P0[2],P0[3],P0[4],P0[5],     pw0[0]=PKW(P0,0), pw0[1]=PKW(P0,2), pw0); \
    VRD(4); SBAR(); GAPA(QKM(C1,1,0,negm), P0[6],P0[7],P0[8],P0[9],     pw0[2]=PKW(P0,4), pw0[3]=PKW(P0,6), pw0); \
    VRD(1); SBAR(); GAPA(QKM(C0,2,1,C0),   P0[10],P0[11],P0[12],P0[13], pw1[0]=PKW(P0,8), pw1[1]=PKW(P0,10), pw1); \
    VRD(5); SBAR(); GAPA(QKM(C1,3,1,C1),   P0[14],P0[15],P1[0],P1[1],   pw1[2]=PKW(P0,12),pw1[3]=PKW(P0,14), pw1); \
    VRD(2); SBAR(); GAPA(QKM(C0,4,2,C0),   P1[2],P1[3],P1[4],P1[5],     pw2[0]=PKW(P1,0), pw2[1]=PKW(P1,2), pw2); \
    VRD(6); SBAR(); GAPA(QKM(C1,5,2,C1),   P1[6],P1[7],P1[8],P1[9],     pw2[2]=PKW(P1,4), pw2[3]=PKW(P1,6), pw2); \
    VRD(3); SBAR(); GAPA(QKM(C0,6,3,C0),   P1[10],P1[11],P1[12],P1[13], pw3[0]=PKW(P1,8), pw3[1]=PKW(P1,10), pw3); \
    VRD(7); SBAR(); GAPA(QKM(C1,7,3,C1),   P1[14],P1[15],0.f,0.f,       pw3[2]=PKW(P1,12),pw3[3]=PKW(P1,14), pw3); \
    l_reg+=sacc; \
    if(GK){DMA_K((t)+3,sl_cur);} if(GV){DMA_V((t)+1,sl_next);} \
    CMASK(C0,C1,t); \
    { float a=MX3(C0[0],C0[1],C1[0]),b=MX3(C0[2],C0[3],C1[1]); a=MX3(a,C1[2],C1[3]); \
      _Pragma("unroll") for(int r=4;r<16;r+=4){a=MX3(a,C0[r],C0[r+1]);b=MX3(b,C0[r+2],C0[r+3]);a=MX3(a,C1[r],C1[r+1]);b=MX3(b,C1[r+2],C1[r+3]);} \
      float rm=__builtin_fmaxf(a,b); { auto rr=__builtin_amdgcn_permlane32_swap(__float_as_uint(rm),__float_as_uint(rm),false,false); rm=__builtin_fmaxf(__uint_as_float(rr[0]),__uint_as_float(rr[1])); } \
      resc=false; \
      if(__builtin_expect(__any(rm>(float)THRL),0)){ const float dl=__builtin_fmaxf(rm,0.f); mhat+=dl; \
        _Pragma("unroll") for(int r=0;r<16;++r){C0[r]-=dl;C1[r]-=dl;} \
        _Pragma("unroll") for(int r=0;r<16;++r)negm[r]=-mhat; asm volatile("":"+v"(negm)); \
        const float f=__builtin_amdgcn_exp2f(-dl); l_reg*=f; if(hi==0)wsf[r32]=f; resc=true; } } \
    SBAR(); \
    GAPB(o[0]=__builtin_amdgcn_mfma_f32_32x32x16_bf16(PAF(0),VFR(0),o[0],0,0,0), C0,0); \
    GAPB(o[1]=__builtin_amdgcn_mfma_f32_32x32x16_bf16(PAF(0),VFR(4),o[1],0,0,0), C0,4); \
    KRD(GL,0); GAPB(o[0]=__builtin_amdgcn_mfma_f32_32x32x16_bf16(PAF(1),VFR(1),o[0],0,0,0), C0,8); \
    KRD(GL,1); GAPB(o[1]=__builtin_amdgcn_mfma_f32_32x32x16_bf16(PAF(1),VFR(5),o[1],0,0,0), C0,12); \
    KRD(GL,2); GAPB(o[0]=__builtin_amdgcn_mfma_f32_32x32x16_bf16(PAF(2),VFR(2),o[0],0,0,0), C1,0); \
    KRD(GL,3); GAPB(o[1]=__builtin_amdgcn_mfma_f32_32x32x16_bf16(PAF(2),VFR(6),o[1],0,0,0), C1,4); \
    GAPB(o[0]=__builtin_amdgcn_mfma_f32_32x32x16_bf16(PAF(3),VFR(3),o[0],0,0,0), C1,8); \
    GAPB(o[1]=__builtin_amdgcn_mfma_f32_32x32x16_bf16(PAF(3),VFR(7),o[1],0,0,0), C1,12); \
    }while(0)
  int t=1;
  #undef CMASK
  #define CMASK(P0,P1,t) do{}while(0)
  for(;t+5<NT;t+=2){
    STEP(pB0,pB1,pA0,pA1,t,true,true,true);     WAIT_BAR(2); RESC(); ROT();
    STEP(pA0,pA1,pB0,pB1,t+1,true,true,true);   WAIT_BAR(2); RESC(); ROT();
  }
  #undef CMASK
  #define CMASK(P0,P1,t) do{}while(0)
  #define ENDW(tt) do{ if((tt)+3<NT){WAIT_BAR(2);} else if((tt)+2<NT){WAIT_BAR(1);} else {WAIT_BAR(0);} }while(0)
  for(;t+1<NT;t+=2){
    STEP(pB0,pB1,pA0,pA1,t,(t+3<NT),(t+1<NT),(t+1<NT));       ENDW(t);   RESC(); ROT();
    STEP(pA0,pA1,pB0,pB1,t+1,(t+4<NT),(t+2<NT),(t+2<NT));     ENDW(t+1); RESC(); ROT();
  }
  STEP(pB0,pB1,pA0,pA1,NT-1,false,false,false); RESC();
  { float sacc=pB0[0]+pB0[1]; _Pragma("unroll") for(int r=2;r<16;++r)sacc+=pB0[r]; _Pragma("unroll") for(int r=0;r<16;++r)sacc+=pB1[r]; l_reg+=sacc;
    pw0=(u32x4){PKW(pB0,0),PKW(pB0,2),PKW(pB0,4),PKW(pB0,6)};pw1=(u32x4){PKW(pB0,8),PKW(pB0,10),PKW(pB0,12),PKW(pB0,14)};pw2=(u32x4){PKW(pB1,0),PKW(pB1,2),PKW(pB1,4),PKW(pB1,6)};pw3=(u32x4){PKW(pB1,8),PKW(pB1,10),PKW(pB1,12),PKW(pB1,14)};
    SBAR(); pv(o,vb0+sl_cur,PAF(0),PAF(1),PAF(2),PAF(3)); }
  #undef PKW
  #undef PAF
  #undef VFR
  #undef PIN
  #undef MX3
  #undef GAPA
  #undef GAPB
  #undef EX
  #undef VRD
  #undef KRD
  #undef STEP
  #undef ENDW
  {auto rr=__builtin_amdgcn_permlane32_swap(__float_as_uint(l_reg),__float_as_uint(l_reg),false,false);l_reg=__uint_as_float(rr[0])+__uint_as_float(rr[1]);}
  if(hi==0)wsf[32+r32]=l_reg;asm volatile("s_waitcnt lgkmcnt(0)":::"memory");
  float rli[16];
  #pragma unroll
  for(int r=0;r<16;++r)rli[r]=__builtin_amdgcn_rcpf(wsf[32+crow(r,hi)]);
  bf16*Ow=Ob+(long)(wid*QBLK)*ldo;
  { bf16*stg=(bf16*)(shm+LDS_OST)+wid*2048;
    #pragma unroll
    for(int r=0;r<16;++r){const int orow=crow(r,hi);
      #pragma unroll
      for(int d0=0;d0<2;++d0)stg[orow*64+d0*32+r32]=__float2bfloat16(o[d0][r]*rli[r]);}
    asm volatile("s_waitcnt lgkmcnt(0)":::"memory");
    #pragma unroll
    for(int i_=0;i_<1;++i_){}
    bf16*stash=(bf16*)(shm+LDS_BYTES)+wid*2048;
    #pragma unroll
    for(int i=0;i<4;++i){const int row=i*8+(lane>>3),ch=lane&7; const u32x4 v=*(const u32x4*)(stg+row*64+ch*8);
      if(MODE==0){ATTN_STORE16(Ow+(long)row*ldo+ch*8,v);}
      else if(MODE==1){*(u32x4*)(stash+row*64+ch*8)=v;}
      else{const u32x4 v0=*(const u32x4*)(stash+row*64+ch*8); float x[8];
        #pragma unroll
        for(int j=0;j<4;++j){x[2*j]=__uint_as_float(v0[j]<<16)-lam*__uint_as_float(v[j]<<16); x[2*j+1]=__uint_as_float(v0[j]&0xffff0000u)-lam*__uint_as_float(v[j]&0xffff0000u);}
        float ss=0.f;
        #pragma unroll
        for(int j=0;j<8;++j)ss+=x[j]*x[j];
        ss+=bperm(lane^1,ss);ss+=bperm(lane^2,ss);ss+=bperm(lane^4,ss);
        const float rr=post/sqrtf(ss*(1.0f/64.0f)+1e-6f); u32x4 w;
        #pragma unroll
        for(int j=0;j<4;++j)w[j]=cvtpk_s(x[2*j]*rr*gsub[ch*8+2*j],x[2*j+1]*rr*gsub[ch*8+2*j+1]);
        ATTN_STORE16(Ow+(long)row*ldo+ch*8,w);} } }
  asm volatile("s_waitcnt lgkmcnt(0)\n\ts_barrier":::"memory");
  #undef DMA_K
  #undef DMA_V
  #undef CMASK
  #undef START
  #undef RESC
  #undef ROT
}
constexpr int ATTN_LDS_BYTES=LDS_BYTES;
#undef SBAR
#undef WAIT_BAR
}

#define GAS __attribute__((address_space(1)))
#define LAS __attribute__((address_space(3)))
typedef unsigned short bf16;
typedef unsigned v4u __attribute__((ext_vector_type(4)));
typedef float f32x4 __attribute__((ext_vector_type(4)));
typedef short bf16x8 __attribute__((ext_vector_type(8)));
typedef GAS unsigned gu32;
typedef GAS unsigned long long gu64;
#define RLX_AGENT __ATOMIC_RELAXED, __HIP_MEMORY_SCOPE_AGENT
#define LDS_WAIT() asm volatile("s_waitcnt lgkmcnt(0)" ::: "memory")
#define VM_WAIT() asm volatile("s_waitcnt vmcnt(0)" ::: "memory")
__device__ __forceinline__ unsigned long long rt() { return __builtin_amdgcn_s_memrealtime(); }
__device__ __forceinline__ unsigned f2bf(float f) { unsigned u = __builtin_bit_cast(unsigned, f); return (u + 0x7fffu + ((u >> 16) & 1u)) >> 16; }
__device__ __forceinline__ unsigned pk2(float lo, float hi) { return f2bf(lo) | (f2bf(hi) << 16); }

#define XB_TMO      128
#define XB_XCNT(j)  (256  + 64 * (j))
#define XB_XSUB(j)  (1280 + 64 * (j))
#define XB_XGEN(j)  (2304 + 64 * (j))
#define XB_TOP      3328
#define XB_TOPGEN   3392
#define XCD_BAR_WORDS 3456
#define XB_SPIN_CAP (1u << 18)

__device__ __forceinline__ unsigned xb_ld(unsigned* p)              { return __hip_atomic_load(p, __ATOMIC_RELAXED, __HIP_MEMORY_SCOPE_AGENT); }
__device__ __forceinline__ unsigned xb_add(unsigned* p, unsigned v) { return __hip_atomic_fetch_add(p, v, __ATOMIC_RELAXED, __HIP_MEMORY_SCOPE_AGENT); }
__device__ __forceinline__ unsigned xb_xcc_id() { return (unsigned)__builtin_amdgcn_s_getreg((3 << 11) | 20) & 0xFu; }
#define XB_SPIN(cond, bar) do { unsigned _sp = 0; while (cond) { __builtin_amdgcn_s_sleep(1); \
    if ((++_sp & 255u) == 0u) { if (xb_ld(&(bar)[XB_TMO])) break; if (_sp > XB_SPIN_CAP) { atomicAdd(&(bar)[XB_TMO], 1u); break; } } } } while (0)

struct XcdBarrier {
    unsigned* bar; unsigned x;
    volatile LAS unsigned* st;
};

__device__ __forceinline__ XcdBarrier xcd_barrier_post(unsigned* bar, volatile LAS unsigned* st) {
    XcdBarrier b; b.bar = bar; b.x = xb_xcc_id(); b.st = st;
    if (threadIdx.x == 0) (void)xb_add(&bar[XB_XCNT(b.x)], 1u);
    return b;
}
__device__ __forceinline__ void xcd_barrier_complete(unsigned* bar, unsigned x, unsigned& nloc, unsigned& nx) {
    const unsigned G = gridDim.x * gridDim.y * gridDim.z;
    unsigned sum, cnt, mine, sp = 0u;
    for (;;) {
        sum = 0u; cnt = 0u; mine = 0u;
#pragma unroll
        for (unsigned j = 0; j < 16; ++j) { const unsigned c = xb_ld(&bar[XB_XCNT(j)]); sum += c; cnt += (c > 0u) ? 1u : 0u; mine = (j == x) ? c : mine; }
        if (sum == G) break;
        __builtin_amdgcn_s_sleep(1);
        if ((++sp & 255u) == 0u) { if (xb_ld(&bar[XB_TMO])) break; if (sp > XB_SPIN_CAP) { atomicAdd(&bar[XB_TMO], 1u); break; } }
    }
    nloc = mine > 0u ? mine : 1u; nx = cnt > 0u ? cnt : 1u;
}

__device__ __forceinline__ void xcd_barrier(const XcdBarrier& b) {
    asm volatile("s_waitcnt vmcnt(0)" ::: "memory");
    __syncthreads();
    if (threadIdx.x == 0) {
        unsigned* bar = b.bar; unsigned xq = b.x; asm volatile("" : "+s"(bar), "+s"(xq));
        __builtin_amdgcn_s_waitcnt(0);
        unsigned nloc = b.st[0], nx = b.st[1];
        if (nloc == 0u) { xcd_barrier_complete(bar, xq, nloc, nx); b.st[0] = nloc; b.st[1] = nx; }
        const unsigned old = xb_add(&bar[XB_XSUB(xq)], 1u);
        const unsigned gen = old / nloc;
        if (old + 1u == (gen + 1u) * nloc) {
            __builtin_amdgcn_fence(__ATOMIC_RELEASE, "agent");
            asm volatile("s_waitcnt vmcnt(0)" ::: "memory");
            const unsigned og = xb_add(&bar[XB_TOP], 1u);
            const unsigned tg = og / nx;
            if (og + 1u == (tg + 1u) * nx) xb_add(&bar[XB_TOPGEN], 1u);
            else XB_SPIN(xb_ld(&bar[XB_TOPGEN]) == tg, bar);
            __builtin_amdgcn_fence(__ATOMIC_ACQUIRE, "agent");
            xb_add(&bar[XB_XGEN(xq)], 1u);
            asm volatile("s_waitcnt vmcnt(0)" ::: "memory");
        } else {
            XB_SPIN(xb_ld(&bar[XB_XGEN(xq)]) == gen, bar);
            __builtin_amdgcn_fence(__ATOMIC_ACQUIRE, "agent");
            asm volatile("s_waitcnt vmcnt(0)" ::: "memory");
        }
    }
    __syncthreads();
}

constexpr int NWAVES = 8, NTHR = 512;
constexpr int BATCH = 2, SEQ = 8192, DM = 1024, MROWS = BATCH * SEQ, DEPTH = 2;
constexpr int D_IN = 2576, NPROJ = 2560, DFF = 2816, NFF = 5632;
constexpr int P_MLQ = 0, P_MLK = 256, P_MLV = 512, P_MLO = 768, P_POOL = 1024, P_DQ = 1280, P_DK = 1536, P_DV = 1792, P_GQ = 2048, P_GK = 2304, P_GV = 2432;
constexpr float LOG2E = 1.4426950408889634f;
constexpr float C2D = 0.17677669529663687f * LOG2E;
constexpr float C2G = 0.125f * LOG2E;
constexpr float C2X = 0.0625f * LOG2E;
constexpr size_t MiB = 1u << 20;
constexpr size_t WS_CTL = 0, CTL_ZERO_BYTES = 1 * MiB;
constexpr size_t WS_ROPE = 1 * MiB;
constexpr size_t WS_SSQ = 2 * MiB;
constexpr size_t WS_HSSQ = 3 * MiB;
constexpr size_t WS_PSUM = 4 * MiB;
constexpr size_t WS_GATES = 5 * MiB;
constexpr size_t WS_MLSC = 6 * MiB;
constexpr size_t WS_WG = 6 * MiB + 256 * 1024;
constexpr size_t WS_NLOC = 7 * MiB;
constexpr size_t WS_MEMN = 8 * MiB;
constexpr size_t WS_KVRAW = 10 * MiB;
constexpr size_t WS_KM = 18 * MiB;
constexpr size_t WS_VMT = 20 * MiB;
constexpr size_t WS_W = 22 * MiB, W_LAYER = 32 * MiB;
constexpr size_t W_IN = 0, W_OUT = 5 * MiB, W_CQ = 7 * MiB, W_CKV = 9 * MiB, W_CO = 13 * MiB, W_FI = 15 * MiB, W_FO = 26 * MiB;
constexpr size_t WS_XB = 86 * MiB;
constexpr size_t WS_BIG = 118 * MiB;
constexpr size_t WS_PROJ = WS_BIG, WS_DQP = WS_BIG + 80 * MiB, WS_YCAT = WS_BIG + 96 * MiB;
constexpr size_t WS_CQ = WS_BIG, WS_PT = WS_BIG + 32 * MiB, WS_CO = WS_BIG + 64 * MiB;
constexpr size_t WS_ACT = WS_BIG;
constexpr size_t WS_END = 256 * MiB;
static_assert(WS_YCAT + 32 * MiB <= WS_END && WS_ACT + 88 * MiB <= WS_END, "d_ws map");
constexpr int CW_BAR = 4096;
constexpr int RING_OFF = 0, RING_BYTES = 131072;
constexpr int LDSCTL_OFF = RING_BYTES, MISC_OFF = LDSCTL_OFF + 320;
constexpr int LDS_BYTES = 147456;

typedef unsigned v2u __attribute__((ext_vector_type(2)));
typedef float f32x2 __attribute__((ext_vector_type(2)));
typedef short bf16x8_t __attribute__((ext_vector_type(8)));
__device__ __forceinline__ float bflo(unsigned u) { return __uint_as_float(u << 16); }
__device__ __forceinline__ float bfhi(unsigned u) { return __uint_as_float(u & 0xffff0000u); }
__device__ __forceinline__ float bf1(bf16 u) { return __uint_as_float((unsigned)u << 16); }
__device__ __forceinline__ float wave_sum_(float v, int lane) {
#pragma unroll
    for (int o = 1; o < 64; o <<= 1) v += SHX(v, o);
    return v;
}
__device__ __forceinline__ float wave_max_(float v, int lane) {
#pragma unroll
    for (int o = 1; o < 64; o <<= 1) v = fmaxf(v, SHX(v, o));
    return v;
}
#define wave_sum(v) wave_sum_((v), lane)
#define wave_max(v) wave_max_((v), lane)
__device__ __forceinline__ float scan_add(float v, int lane) {
#pragma unroll
    for (int o = 1; o < 64; o <<= 1) { const float t = SHU(v, o); v = (lane >= o) ? v + t : v; }
    return v;
}
__device__ __forceinline__ float scan_max_up(float v, int lane) {
#pragma unroll
    for (int o = 1; o < 64; o <<= 1) { const float t = SHU(v, o); v = (lane >= o) ? fmaxf(v, t) : v; }
    return v;
}
__device__ __forceinline__ float scan_max_down(float v, int lane) {
#pragma unroll
    for (int o = 1; o < 64; o <<= 1) { const float t = SHD(v, o); v = (lane + o < 64) ? fmaxf(v, t) : v; }
    return v;
}
__device__ __forceinline__ float logsig(float x) { return fminf(x, 0.f) - log1pf(expf(-fabsf(x))); }

struct Args { const float* in[28]; float* out; unsigned char* ws; int ph_lo, ph_hi; };

__device__ __forceinline__ void tr_item(const float* W, int Nsrc, int K, int src_col0, bf16* WT, int dst_row0, const float* gk, float scale, LAS float* scr, int kb, int lane) {
    const int k0 = 64 * kb;
    float wv_[32];
#pragma unroll
    for (int i = 0; i < 32; ++i) wv_[i] = W[(size_t)(k0 + 2 * i + (lane >> 5)) * Nsrc + src_col0 + (lane & 31)];
#pragma unroll
    for (int i = 0; i < 32; ++i) { const int kk = 2 * i + (lane >> 5); const float g = gk ? gk[k0 + kk] * scale : scale; scr[kk * 33 + (lane & 31)] = wv_[i] * g; }
    LDS_WAIT(); asm volatile("" ::: "memory");
    const int c = lane & 7;
#pragma unroll
    for (int j = 0; j < 4; ++j) { const int n = (lane >> 3) + 8 * j; const LAS float* s = scr + (8 * c) * 33 + n;
        v4u o; o.x = pk2(s[0 * 33], s[1 * 33]); o.y = pk2(s[2 * 33], s[3 * 33]); o.z = pk2(s[4 * 33], s[5 * 33]); o.w = pk2(s[6 * 33], s[7 * 33]);
        *(v4u*)(WT + (size_t)(dst_row0 + n) * K + k0 + 8 * c) = o; }
    LDS_WAIT(); asm volatile("" ::: "memory");
}
constexpr int CONV_ITEMS = 16 * 80 + 16 * 32 * 3 + 16 * 64 + 16 * 176 + 44 * 32, CONV_SPLIT = 5000;
__device__ __forceinline__ void convert_weights(const __attribute__((address_space(4))) Args* ap, LAS unsigned char* lds, int l, int w0, int nw, int wave, int lane, int it_lo, int it_hi, bool do_wg) {
    unsigned char* ws = ap->ws;
    LAS float* scr = (LAS float*)(lds + RING_OFF + wave * 16384);
    constexpr int I_IN = 16 * 80, I_OUT = 16 * 32, I_CQ = 16 * 32, I_CKV = 16 * 64, I_CO = 16 * 32, I_FI = 16 * 176, I_FO = 44 * 32;
    constexpr int I_LAYER = I_IN + I_OUT + I_CQ + I_CKV + I_CO + I_FI + I_FO;
    static_assert(I_LAYER == CONV_ITEMS, "item count");
    for (int it = it_lo + w0; it < it_hi; it += nw) {
        int r = it;
        unsigned char* wl = ws + WS_W + (size_t)l * W_LAYER;
        if (r < I_IN) { const int kb = r / 80, nb = r % 80, d0 = 32 * nb;
            tr_item(ap->in[3] + (size_t)l * 1024 * D_IN, D_IN, 1024, d0 + (d0 >= 1024 ? 16 : 0), (bf16*)(wl + W_IN), d0, ap->in[2] + l * 1024, (d0 >= 256 && d0 < 512) ? 0.125f : 1.0f, scr, kb, lane); continue; } r -= I_IN;
        if (r < I_OUT) { tr_item(ap->in[15] + (size_t)l * 1024 * 1024, 1024, 1024, 32 * (r % 32), (bf16*)(wl + W_OUT), 32 * (r % 32), nullptr, 1.0f, scr, r / 32, lane); continue; } r -= I_OUT;
        if (r < I_CQ) { tr_item(ap->in[18] + (size_t)l * 1024 * 1024, 1024, 1024, 32 * (r % 32), (bf16*)(wl + W_CQ), 32 * (r % 32), ap->in[16] + l * 1024, 1.0f, scr, r / 32, lane); continue; } r -= I_CQ;
        if (r < I_CKV) { tr_item(ap->in[19] + (size_t)l * 1024 * 2048, 2048, 1024, 32 * (r % 64), (bf16*)(wl + W_CKV), 32 * (r % 64), nullptr, 1.0f, scr, r / 64, lane); continue; } r -= I_CKV;
        if (r < I_CO) { tr_item(ap->in[22] + (size_t)l * 1024 * 1024, 1024, 1024, 32 * (r % 32), (bf16*)(wl + W_CO), 32 * (r % 32), nullptr, 1.0f, scr, r / 32, lane); continue; } r -= I_CO;
        if (r < I_FI) { const int kb = r / 176, nb = r % 176, d0 = 32 * nb, tile = d0 >> 8, within = d0 & 255;
            const int src = within < 128 ? 128 * tile + within : DFF + 128 * tile + (within - 128);
            tr_item(ap->in[24] + (size_t)l * 1024 * NFF, NFF, 1024, src, (bf16*)(wl + W_FI), d0, ap->in[23] + l * 1024, 1.0f, scr, kb, lane); continue; } r -= I_FI;
        tr_item(ap->in[27] + (size_t)l * DFF * 1024, 1024, DFF, 32 * (r % 32), (bf16*)(wl + W_FO), 32 * (r % 32), nullptr, 1.0f, scr, r / 32, lane);
    }
    if (do_wg) { bf16* WG = (bf16*)(ws + WS_WG) + (size_t)l * 2 * 16384; const float* Win = ap->in[3] + (size_t)l * 1024 * D_IN; const float* gm = ap->in[2] + l * 1024;
      for (int e = w0 * 64 + lane; e < 16384; e += nw * 64) { const int k = e >> 4, j = e & 15; const float v = Win[(size_t)k * D_IN + 1024 + j] * gm[k]; const unsigned h = f2bf(v);
          WG[j * 1024 + k] = (bf16)h; WG[16384 + j * 1024 + k] = (bf16)f2bf(v - __uint_as_float(h << 16)); } }
}
__device__ __forceinline__ void p0_prologue(const __attribute__((address_space(4))) Args* ap, LAS unsigned char* lds, int vcu, int G, int wave, int lane, int tid) {
    unsigned char* ws = ap->ws;
    const int gw = vcu * NWAVES + wave, NGW = G * NWAVES;
    convert_weights(ap, lds, 0, gw, NGW, wave, lane, 0, CONV_ITEMS, true);
    { const float* x = ap->in[0]; bf16* XB = (bf16*)(ws + WS_XB); float* SSQ = (float*)(ws + WS_SSQ);
      for (int m = gw; m < MROWS; m += NGW) { const f32x4* xr = (const f32x4*)(x + (size_t)m * DM) + lane; float s = 0.f;
          unsigned long long* o8 = (unsigned long long*)(XB + (size_t)m * DM) + lane;
#pragma unroll
          for (int j = 0; j < 4; ++j) { const f32x4 v = xr[64 * j]; s += (v[0] * v[0] + v[1] * v[1]) + (v[2] * v[2] + v[3] * v[3]);
              o8[64 * j] = (unsigned long long)pk2(v[0], v[1]) | ((unsigned long long)pk2(v[2], v[3]) << 32); }
          s = wave_sum(s); if (lane < 16) SSQ[(size_t)m * 16 + lane] = (lane == 0) ? s : 0.f; } }
    { const float* mem = ap->in[1]; bf16* MEMN = (bf16*)(ws + WS_MEMN);
      for (int idx = gw; idx < DEPTH * 512; idx += NGW) { const int l = idx >> 9, r = idx & 511; const f32x4* xr = (const f32x4*)(mem + (size_t)r * DM) + lane; const f32x4* gr = (const f32x4*)(ap->in[17] + l * DM) + lane;
          f32x4 v[4]; float s = 0.f;
#pragma unroll
          for (int j = 0; j < 4; ++j) { v[j] = xr[64 * j]; s += (v[j][0] * v[j][0] + v[j][1] * v[j][1]) + (v[j][2] * v[j][2] + v[j][3] * v[j][3]); }
          const float rs = 1.0f / sqrtf(wave_sum(s) * (1.0f / 1024.0f) + 1e-6f);
          unsigned long long* o8 = (unsigned long long*)(MEMN + (size_t)idx * DM) + lane;
#pragma unroll
          for (int j = 0; j < 4; ++j) { const f32x4 g = gr[64 * j]; o8[64 * j] = (unsigned long long)pk2(v[j][0] * rs * g[0], v[j][1] * rs * g[1]) | ((unsigned long long)pk2(v[j][2] * rs * g[2], v[j][3] * rs * g[3]) << 32); } } }
    { float2* RT = (float2*)(ws + WS_ROPE);
      for (int e = vcu * NTHR + tid; e < SEQ * 16; e += G * NTHR) { const int pos = e >> 4, i = e & 15;
          double inv = 1.0; for (int q = 0; q < i; ++q) inv *= 0.56234132519034908;
          const double rev = (double)pos * inv * 0.15915494309189535; double fr = rev - floor(rev); if (fr > 0.5) fr -= 1.0;
          const float ang = (float)(fr * 6.283185307179586);
          RT[e] = make_float2(cosf(ang), sinf(ang)); } }
}

__device__ __forceinline__ void gates_phase(const bf16* XB, const bf16* WG, const float* SSQ, float* GATES, int gw, int NGW, int lane) {
    const int r = lane & 15, q = lane >> 4;
    for (int tt = gw; tt < MROWS / 16; tt += NGW) {
        const bf16* xa = XB + (size_t)(tt * 16 + r) * DM + 8 * q; const bf16* wh = WG + r * 1024 + 8 * q; const bf16* wl_ = wh + 16384;
        f32x4 acc = (f32x4){0.f, 0.f, 0.f, 0.f};
#pragma unroll 8
        for (int kk = 0; kk < 32; ++kk) { const bf16x8_t a = *(const bf16x8_t*)(xa + 32 * kk), bh = *(const bf16x8_t*)(wh + 32 * kk), bl = *(const bf16x8_t*)(wl_ + 32 * kk);
            acc = __builtin_amdgcn_mfma_f32_16x16x32_bf16(a, bh, acc, 0, 0, 0); acc = __builtin_amdgcn_mfma_f32_16x16x32_bf16(a, bl, acc, 0, 0, 0); }
#pragma unroll
        for (int i = 0; i < 4; ++i) { const int t = tt * 16 + 4 * q + i; const float rs = 1.0f / sqrtf(pg8::sum16(SSQ + (size_t)t * 16) * (1.0f / 1024.0f) + 1e-6f); GATES[(size_t)t * 16 + r] = acc[i] * rs; }
    }
}

struct QKRaw { unsigned dqa, dqb, dka, dkb, gqa, gqb; bf16 gk1, gk2; float2 dcs0, dcs1, qcs0, qcs1, kcs; };
template <bool DIFF, bool GQA> __device__ __forceinline__ void qk_load(int t, const bf16* PROJ, const float2* RT, int lane, QKRaw& w) {
    const int pos = t & (SEQ - 1), prow = pos >> 6, pcol = pos & 63; const bf16* pr = PROJ + (size_t)t * NPROJ;
    if (DIFF) { const int grp = lane >> 3, i = 2 * (lane & 7); w.dcs0 = RT[pos * 16 + i]; w.dcs1 = RT[pos * 16 + i + 1];
      const bf16* p = pr + P_DQ + grp * 32; w.dqa = *(const unsigned*)(p + i); w.dqb = *(const unsigned*)(p + 16 + i);
      const bf16* k = pr + P_DK + grp * 32; w.dka = *(const unsigned*)(k + i); w.dkb = *(const unsigned*)(k + 16 + i); }
    if (GQA) { const int head = lane >> 4, sub = lane & 15, half = sub >> 3, i = 2 * (sub & 7); const int pp = half ? pcol : prow; w.qcs0 = RT[pp * 16 + i]; w.qcs1 = RT[pp * 16 + i + 1];
      const bf16* p = pr + P_GQ + head * 64 + half * 32; w.gqa = *(const unsigned*)(p + i); w.gqb = *(const unsigned*)(p + 16 + i); }
    if (GQA) { const int head = lane >> 5, sub = lane & 31, half = sub >> 4, i = sub & 15; const int pp = half ? pcol : prow; w.kcs = RT[pp * 16 + i];
      const bf16* p = pr + P_GK + head * 64 + half * 32; w.gk1 = p[i]; w.gk2 = p[16 + i]; }
}
template <bool DIFF, bool GQA> __device__ __forceinline__ void qk_finish(int t, bf16* PROJ, bf16* DQP, const float* dqn, const float* dkn, const float* gqn, const float* gkn, int lane, const QKRaw& w) {
    bf16* pr = PROJ + (size_t)t * NPROJ;
    if (DIFF) {
        const int grp = lane >> 3, i = 2 * (lane & 7); const float2 cs0 = w.dcs0, cs1 = w.dcs1;
#pragma unroll
        for (int which = 0; which < 2; ++which) {
            bf16* p = pr + (which ? P_DK : P_DQ) + grp * 32; const float* gn = which ? dkn : dqn;
            const unsigned ua = which ? w.dka : w.dqa, ub = which ? w.dkb : w.dqb;
            float x1a = bflo(ua), x1b = bfhi(ua), x2a = bflo(ub), x2b = bfhi(ub);
            float ss = (x1a * x1a + x1b * x1b) + (x2a * x2a + x2b * x2b); ss += SHX(ss, 1); ss += SHX(ss, 2); ss += SHX(ss, 4);
            const float r = 1.0f / sqrtf(ss * (1.0f / 32.0f) + 1e-6f);
            x1a *= r * gn[i]; x1b *= r * gn[i + 1]; x2a *= r * gn[16 + i]; x2b *= r * gn[17 + i];
            float y1a = x1a * cs0.x - x2a * cs0.y, y2a = x2a * cs0.x + x1a * cs0.y, y1b = x1b * cs1.x - x2b * cs1.y, y2b = x2b * cs1.x + x1b * cs1.y;
            if (which == 0) { bf16* q = DQP + (size_t)t * 512 + grp * 64; const int qo = (grp & 1) * 32, zo = 32 - qo;
                *(unsigned*)(q + qo + i) = pk2(y1a * C2D, y1b * C2D); *(unsigned*)(q + qo + 16 + i) = pk2(y2a * C2D, y2b * C2D);
                *(unsigned long long*)(q + zo + 4 * (lane & 7)) = 0ull; }
            else { *(unsigned*)(p + i) = pk2(y1a, y1b); *(unsigned*)(p + 16 + i) = pk2(y2a, y2b); }
        }
    }
    if (GQA) {
        const int head = lane >> 4, sub = lane & 15, half = sub >> 3, i = 2 * (sub & 7); const float2 cs0 = w.qcs0, cs1 = w.qcs1;
        bf16* p = pr + P_GQ + head * 64 + half * 32; const float* gn = gqn + half * 32;
        float x1a = bflo(w.gqa), x1b = bfhi(w.gqa), x2a = bflo(w.gqb), x2b = bfhi(w.gqb);
        float ss = (x1a * x1a + x1b * x1b) + (x2a * x2a + x2b * x2b); ss += SHX(ss, 1); ss += SHX(ss, 2); ss += SHX(ss, 4); ss += SHX(ss, 8);
        const float r = C2G / sqrtf(ss * (1.0f / 64.0f) + 1e-6f);
        x1a *= r * gn[i]; x1b *= r * gn[i + 1]; x2a *= r * gn[16 + i]; x2b *= r * gn[17 + i];
        *(unsigned*)(p + i) = pk2(x1a * cs0.x - x2a * cs0.y, x1b * cs1.x - x2b * cs1.y); *(unsigned*)(p + 16 + i) = pk2(x2a * cs0.x + x1a * cs0.y, x2b * cs1.x + x1b * cs1.y);
    }
    if (GQA) {
        const int head = lane >> 5, sub = lane & 31, half = sub >> 4, i = sub & 15; const float2 cs = w.kcs;
        bf16* p = pr + P_GK + head * 64 + half * 32; const float* gn = gkn + half * 32;
        float x1 = bf1(w.gk1), x2 = bf1(w.gk2);
        float ss = x1 * x1 + x2 * x2; ss += SHX(ss, 1); ss += SHX(ss, 2); ss += SHX(ss, 4); ss += SHX(ss, 8); ss += SHX(ss, 16);
        const float r = 1.0f / sqrtf(ss * (1.0f / 64.0f) + 1e-6f);
        x1 *= r * gn[i]; x2 *= r * gn[16 + i];
        p[i] = (bf16)f2bf(x1 * cs.x - x2 * cs.y); p[16 + i] = (bf16)f2bf(x2 * cs.x + x1 * cs.y);
    }
}

constexpr int LP = 72;
__device__ __forceinline__ void mm_16x32(const LAS bf16* A, const LAS bf16* Bt, int tr, int tc0, int lane, f32x4& d0, f32x4& d1) {
    const int r = lane & 15, q = lane >> 4;
    const LAS bf16* ap = A + (16 * tr + r) * LP + 8 * q; const LAS bf16* b0 = Bt + (16 * tc0 + r) * LP + 8 * q; const LAS bf16* b1 = b0 + 16 * LP;
#pragma unroll
    for (int kk = 0; kk < 2; ++kk) { const bf16x8_t a = *(const LAS bf16x8_t*)(ap + 32 * kk), x0 = *(const LAS bf16x8_t*)(b0 + 32 * kk), x1 = *(const LAS bf16x8_t*)(b1 + 32 * kk);
        d0 = __builtin_amdgcn_mfma_f32_16x16x32_bf16(a, x0, d0, 0, 0, 0); d1 = __builtin_amdgcn_mfma_f32_16x16x32_bf16(a, x1, d1, 0, 0, 0); }
}
__device__ __forceinline__ void st_bf16(LAS bf16* p, float v) { *p = (bf16)f2bf(v); }
__device__ __forceinline__ void load_tile_b(LAS bf16* dst, const bf16* src, int tid) { const int r = tid >> 3, c8 = (tid & 7) * 8; *(LAS v4u*)(dst + r * LP + c8) = *(const v4u*)(src + (size_t)r * NPROJ + c8); }
__device__ __forceinline__ void load_tile_bT(LAS bf16* dst, const bf16* src, int tid) { const int r = tid & 63, c8 = (tid >> 6) * 8;
    const v4u raw = *(const v4u*)(src + (size_t)r * NPROJ + c8);
    dst[(c8 + 0) * LP + r] = (bf16)(raw.x & 0xffffu); dst[(c8 + 1) * LP + r] = (bf16)(raw.x >> 16); dst[(c8 + 2) * LP + r] = (bf16)(raw.y & 0xffffu); dst[(c8 + 3) * LP + r] = (bf16)(raw.y >> 16);
    dst[(c8 + 4) * LP + r] = (bf16)(raw.z & 0xffffu); dst[(c8 + 5) * LP + r] = (bf16)(raw.z >> 16); dst[(c8 + 6) * LP + r] = (bf16)(raw.w & 0xffffu); dst[(c8 + 7) * LP + r] = (bf16)(raw.w >> 16); }
__device__ __forceinline__ void pool_item(LAS unsigned char* lds, int item, const bf16* PROJ, const float* pw, const float* pscale, bf16* YCAT, int tid) {
    const int tile = item >> 2, g = item & 3, win = 2 << g, lane = tid & 63, wave = tid >> 6;
    const int trow0 = tile * 64, pos0 = trow0 & (SEQ - 1);
    LAS float* U = (LAS float*)lds;
    LAS bf16* PB = (LAS bf16*)(U + 80 * 64);
    LAS bf16* WgT = PB + 64 * LP;
    for (int e = tid; e < 640; e += NTHR) { const int jj = e >> 3, c8 = (e & 7) * 8; const int p = pos0 - 8 + jj;
        v4u raw = (v4u){0u, 0u, 0u, 0u};
        if (p >= 0 && p < SEQ) raw = *(const v4u*)(PROJ + (size_t)(trow0 - 8 + jj) * NPROJ + P_POOL + g * 64 + c8);
        LAS float* d = U + jj * 64 + c8; d[0] = bflo(raw.x); d[1] = bfhi(raw.x); d[2] = bflo(raw.y); d[3] = bfhi(raw.y); d[4] = bflo(raw.z); d[5] = bfhi(raw.z); d[6] = bflo(raw.w); d[7] = bfhi(raw.w); }
    { const int c = tid & 63, e8 = (tid >> 6) * 8; const f32x4 a = *(const f32x4*)(pw + g * 4096 + c * 64 + e8), b = *(const f32x4*)(pw + g * 4096 + c * 64 + e8 + 4);
#pragma unroll
      for (int j = 0; j < 4; ++j) { st_bf16(WgT + (e8 + j) * LP + c, a[j]); st_bf16(WgT + (e8 + 4 + j) * LP + c, b[j]); } }
    __syncthreads();
    { const int tl = tid >> 3, c8 = (tid & 7) * 8, pos = pos0 + tl;
      int lo = pos - win / 2, hi = pos - win / 2 + win - 1; lo = lo < 0 ? 0 : lo; hi = hi > SEQ - 1 ? SEQ - 1 : hi;
      float s[8];
#pragma unroll
      for (int q = 0; q < 8; ++q) s[q] = 0.f;
      for (int p = lo; p <= hi; ++p) { const LAS float* u = U + (p - pos0 + 8) * 64 + c8;
#pragma unroll
          for (int q = 0; q < 8; ++q) s[q] += u[q]; }
      const float inv = 1.0f / (float)(hi - lo + 1); const LAS float* uc = U + (tl + 8) * 64 + c8;
      v4u o; o.x = pk2(s[0] * inv - uc[0], s[1] * inv - uc[1]); o.y = pk2(s[2] * inv - uc[2], s[3] * inv - uc[3]); o.z = pk2(s[4] * inv - uc[4], s[5] * inv - uc[5]); o.w = pk2(s[6] * inv - uc[6], s[7] * inv - uc[7]);
      *(LAS v4u*)(PB + tl * LP + c8) = o; }
    __syncthreads();
    { const int tr = wave >> 1, tc0 = (wave & 1) * 2, q = lane >> 4, cl = lane & 15; f32x4 y[2]; y[0] = (f32x4){0.f, 0.f, 0.f, 0.f}; y[1] = y[0];
      mm_16x32(PB, WgT, tr, tc0, lane, y[0], y[1]);
#pragma unroll
      for (int x = 0; x < 2; ++x) { const int e = 16 * (tc0 + x) + cl; const float sc = pscale[g * 64 + e];
#pragma unroll
          for (int i = 0; i < 4; ++i) YCAT[(size_t)(trow0 + 16 * tr + 4 * q + i) * DM + 256 + g * 64 + e] = (bf16)f2bf(y[x][i] * sc); } }
    __syncthreads();
}
__device__ __forceinline__ void ml_gates(const float* GATES, const float* bi, const float* bfz, int trow0, int h, int lane, float& lfF, float& liF, float& lfB, float& liB) {
    const float* g = GATES + (size_t)(trow0 + lane) * 16;
    liF = g[h] + bi[h]; lfF = logsig(g[4 + h] + bfz[h]); liB = g[8 + h] + bi[4 + h]; lfB = logsig(g[12 + h] + bfz[4 + h]);
}
__device__ __forceinline__ void load_tile_T(LAS float* dstT, const bf16* src, int tid) {
    const int r = tid >> 3, c8 = (tid & 7) * 8; const v4u raw = *(const v4u*)(src + (size_t)r * NPROJ + c8);
    dstT[(c8 + 0) * 64 + r] = bflo(raw.x); dstT[(c8 + 1) * 64 + r] = bfhi(raw.x); dstT[(c8 + 2) * 64 + r] = bflo(raw.y); dstT[(c8 + 3) * 64 + r] = bfhi(raw.y);
    dstT[(c8 + 4) * 64 + r] = bflo(raw.z); dstT[(c8 + 5) * 64 + r] = bfhi(raw.z); dstT[(c8 + 6) * 64 + r] = bflo(raw.w); dstT[(c8 + 7) * 64 + r] = bfhi(raw.w);
}
__device__ __forceinline__ void load_tile(LAS float* dst, const bf16* src, int tid) {
    const int r = tid >> 3, c8 = (tid & 7) * 8; const v4u raw = *(const v4u*)(src + (size_t)r * NPROJ + c8); LAS float* d = dst + r * 64 + c8;
    d[0] = bflo(raw.x); d[1] = bfhi(raw.x); d[2] = bflo(raw.y); d[3] = bfhi(raw.y); d[4] = bflo(raw.z); d[5] = bfhi(raw.z); d[6] = bflo(raw.w); d[7] = bfhi(raw.w);
}
__device__ __forceinline__ void ml_local_item(LAS unsigned char* lds, int item, const bf16* PROJ, const float* GATES, const float* bi, const float* bfz, float* CLOC, float* NLOC, float* GG, float* MLOC, int tid) {
    const int b = item >> 9, h = (item >> 7) & 3, c = item & 127, trow0 = b * SEQ + c * 64, lane = tid & 63, wave = tid >> 6;
    LAS bf16* kwF = (LAS bf16*)lds; LAS bf16* kwB = kwF + 64 * LP; LAS bf16* vT = kwB + 64 * LP; LAS float* wS = (LAS float*)(vT + 64 * LP);
    const int seqF = (b * 4 + h) * 2;
    load_tile_bT(vT, PROJ + (size_t)trow0 * NPROJ + P_MLV + h * 64, tid);
    if (wave == 0) { float lfF, liF, lfB, liB; ml_gates(GATES, bi, bfz, trow0, h, lane, lfF, liF, lfB, liB);
        const float bF = scan_add(lfF, lane), gF = SHI(bF, 63), aF = gF - bF + liF, mF = wave_max(aF);
        const float pB = scan_add(lfB, lane), gB = SHI(pB, 63), bB = gB - pB + lfB, aB = gB - bB + liB, mB = wave_max(aB);
        wS[2 * lane] = expf(aF - mF); wS[2 * lane + 1] = expf(aB - mB);
        if (lane == 0) { GG[seqF * 128 + c] = gF; MLOC[seqF * 128 + c] = mF; GG[(seqF + 1) * 128 + c] = gB; MLOC[(seqF + 1) * 128 + c] = mB; } }
    __syncthreads();
    { const int r = tid & 63, c8 = (tid >> 6) * 8; const v4u raw = *(const v4u*)(PROJ + (size_t)(trow0 + r) * NPROJ + P_MLK + h * 64 + c8); const float wf = wS[2 * r], wb = wS[2 * r + 1];
      const float kv[8] = {bflo(raw.x), bfhi(raw.x), bflo(raw.y), bfhi(raw.y), bflo(raw.z), bfhi(raw.z), bflo(raw.w), bfhi(raw.w)};
#pragma unroll
      for (int j = 0; j < 8; ++j) { st_bf16(kwF + (c8 + j) * LP + r, kv[j] * wf); st_bf16(kwB + (c8 + j) * LP + r, kv[j] * wb); } }
    __syncthreads();
    { const int tr = wave >> 1, tc0 = (wave & 1) * 2, q = lane >> 4, cl = lane & 15; f32x4 cf[2], cb[2]; cf[0] = (f32x4){0.f, 0.f, 0.f, 0.f}; cf[1] = cf[0]; cb[0] = cf[0]; cb[1] = cf[0];
      mm_16x32(kwF, vT, tr, tc0, lane, cf[0], cf[1]); mm_16x32(kwB, vT, tr, tc0, lane, cb[0], cb[1]);
      float* oF = CLOC + (size_t)(seqF * 128 + c) * 4096; float* oB = CLOC + (size_t)((seqF + 1) * 128 + c) * 4096;
#pragma unroll
      for (int x = 0; x < 2; ++x)
#pragma unroll
          for (int i = 0; i < 4; ++i) { const int o = (16 * tr + 4 * q + i) * 64 + 16 * (tc0 + x) + cl; oF[o] = cf[x][i]; oB[o] = cb[x][i]; } }
    { const int d = tid >> 3, seg = tid & 7; const v4u a = *(const LAS v4u*)(kwF + d * LP + 8 * seg), bq = *(const LAS v4u*)(kwB + d * LP + 8 * seg);
      float nf = ((bflo(a.x) + bfhi(a.x)) + (bflo(a.y) + bfhi(a.y))) + ((bflo(a.z) + bfhi(a.z)) + (bflo(a.w) + bfhi(a.w)));
      float nb = ((bflo(bq.x) + bfhi(bq.x)) + (bflo(bq.y) + bfhi(bq.y))) + ((bflo(bq.z) + bfhi(bq.z)) + (bflo(bq.w) + bfhi(bq.w)));
      nf += SHX(nf, 1); nf += SHX(nf, 2); nf += SHX(nf, 4); nb += SHX(nb, 1); nb += SHX(nb, 2); nb += SHX(nb, 4);
      if (seg == 0) { NLOC[(size_t)(seqF * 128 + c) * 64 + d] = nf; NLOC[(size_t)((seqF + 1) * 128 + c) * 64 + d] = nb; } }
    __syncthreads();
}
__device__ __forceinline__ void mem_post_row(int idx, const float* KVRAW, const float* cqn, const float* ckn, bf16* KM, bf16* VMT, int lane) {
    const int l = idx >> 9, r = idx & 511, b = r >> 8, key = r & 255; const float* raw = KVRAW + (size_t)idx * 2048;
    const f32x4 gq = *(const f32x4*)(cqn + l * 256 + 4 * lane), gk = *(const f32x4*)(ckn + l * 256 + 4 * lane);
#pragma unroll
    for (int h = 0; h < 4; ++h) { const f32x4 k4 = *(const f32x4*)(raw + h * 256 + 4 * lane);
        const float ss = wave_sum((k4[0] * k4[0] + k4[1] * k4[1]) + (k4[2] * k4[2] + k4[3] * k4[3])); const float rr = C2X / sqrtf(ss * (1.0f / 256.0f) + 1e-6f);
        v2u w; w.x = pk2(k4[0] * rr * gk[0] * gq[0], k4[1] * rr * gk[1] * gq[1]); w.y = pk2(k4[2] * rr * gk[2] * gq[2], k4[3] * rr * gk[3] * gq[3]);
        const size_t hb = (size_t)((l * 2 + b) * 4 + h) * 65536;
        *(v2u*)(KM + hb + (size_t)key * 256 + 4 * lane) = w;
        const f32x4 v4 = *(const f32x4*)(raw + 1024 + h * 256 + 4 * lane);
#pragma unroll
        for (int j = 0; j < 4; ++j) VMT[hb + (size_t)(4 * lane + j) * 256 + key] = (bf16)f2bf(v4[j]); }
}
__device__ __forceinline__ void ml_scan(float* CLOC, float* NLOC, const float* GG, const float* MLOC, float* MPREV, int gw, int NGW, int lane) {
    for (int w = gw; w < 16 * 65; w += NGW) {
        const int seq = w / 65, part = w % 65; const bool bwd = (seq & 1) != 0;
        float* base = part < 64 ? CLOC + (size_t)seq * 128 * 4096 + part * 64 : NLOC + (size_t)seq * 128 * 64;
        const long cs = part < 64 ? 4096 : 64; const long stride = bwd ? -cs : cs; float* p0 = base + (bwd ? 127 * cs : 0);
        const int c0 = bwd ? 127 - lane : lane, c1 = bwd ? 63 - lane : 64 + lane;
        const float gg0 = GG[seq * 128 + c0], gg1 = GG[seq * 128 + c1], ml0 = MLOC[seq * 128 + c0], ml1 = MLOC[seq * 128 + c1];
        float loc[128];
        { float* pl = p0;
#pragma unroll
          for (int k = 0; k < 128; ++k) { loc[k] = pl[lane]; pl += stride; asm volatile("" : "+s"(pl)); } }
        float* ps = p0;
        float C = 0.f, m = 0.f; float mp0 = 0.f, mp1 = 0.f;
#pragma unroll
        for (int k = 0; k < 128; ++k) {
            const float g = __int_as_float(__builtin_amdgcn_readlane(__float_as_int(k < 64 ? gg0 : gg1), k & 63)), mlv = __int_as_float(__builtin_amdgcn_readlane(__float_as_int(k < 64 ? ml0 : ml1), k & 63));
            ps[lane] = C; ps += stride; asm volatile("" : "+s"(ps)); if (k < 64) mp0 = (lane == (k & 63)) ? m : mp0; else mp1 = (lane == (k & 63)) ? m : mp1;
            const float mn = fmaxf(g + m, mlv); const float fo = __expf(g + m - mn), fl = __expf(mlv - mn); C = fo * C + fl * loc[k]; m = mn;
        }
        if (part == 64) { MPREV[seq * 128 + c0] = mp0; MPREV[seq * 128 + c1] = mp1; }
    }
}
__device__ __forceinline__ void ml_out_item(LAS unsigned char* lds, int item, const bf16* PROJ, const float* GATES, const float* bi, const float* bfz, const float* CLOC, const float* NLOC, const float* MPREV, const float* gnorm, bf16* YCAT, int tid) {
    const int b = item >> 9, h = (item >> 7) & 3, c = item & 127, trow0 = b * SEQ + c * 64, lane = tid & 63, wave = tid >> 6;
    LAS bf16* qb = (LAS bf16*)lds; LAS bf16* kb = qb + 64 * LP; LAS bf16* vT = kb + 64 * LP; LAS bf16* CpT = vT + 64 * LP; LAS bf16* Wb = CpT + 2 * 64 * LP;
    LAS float* HB = (LAS float*)(Wb + 2 * 64 * LP);
    LAS float* VB = HB + 4096;
    LAS float* VLI = VB + 128;
    LAS float* MT = VLI + 128; LAS float* SI = MT + 128; LAS float* NP = SI + 128; LAS float* INV = NP + 128;
    const bf16* prow = PROJ + (size_t)trow0 * NPROJ; const size_t sc0 = (size_t)((b * 4 + h) * 2) * 128 + c, sc1 = sc0 + 128;
    load_tile_b(qb, prow + P_MLQ + h * 64, tid); load_tile_b(kb, prow + P_MLK + h * 64, tid); load_tile_bT(vT, prow + P_MLV + h * 64, tid);
    { const int d = tid & 63, e8 = (tid >> 6) * 8;
#pragma unroll
      for (int dir = 0; dir < 2; ++dir) { const float* src = CLOC + (dir ? sc1 : sc0) * 4096 + d * 64 + e8; const f32x4 a = *(const f32x4*)src, bq = *(const f32x4*)(src + 4); LAS bf16* dst = CpT + dir * 64 * LP;
#pragma unroll
          for (int j = 0; j < 4; ++j) { st_bf16(dst + (e8 + j) * LP + d, a[j]); st_bf16(dst + (e8 + 4 + j) * LP + d, bq[j]); } } }
    if (tid < 128) NP[tid] = NLOC[((tid >> 6) ? sc1 : sc0) * 64 + (tid & 63)];
    if (wave == 0) { float lfF, liF, lfB, liB; ml_gates(GATES, bi, bfz, trow0, h, lane, lfF, liF, lfB, liB);
        const float bF = scan_add(lfF, lane); const float pB = scan_add(lfB, lane), gB = SHI(pB, 63), bB = gB - pB + lfB;
        VB[lane] = bF; VB[64 + lane] = bB; VLI[lane] = liF; VLI[64 + lane] = liB;
        const float pmF = scan_max_up(liF - bF, lane), pmB = scan_max_down(liB - bB, lane);
        const float eF = bF + MPREV[sc0], mtF = fmaxf(eF, bF + pmF), eB = bB + MPREV[sc1], mtB = fmaxf(eB, bB + pmB);
        MT[lane] = mtF; SI[lane] = expf(eF - mtF); MT[64 + lane] = mtB; SI[64 + lane] = expf(eB - mtB); }
    const int tr = wave >> 1, tc0 = (wave & 1) * 2, q4 = lane >> 4, cl = lane & 15;
    __syncthreads();
    {
        f32x4 sacc[2]; sacc[0] = (f32x4){0.f, 0.f, 0.f, 0.f}; sacc[1] = sacc[0];
        mm_16x32(qb, kb, tr, tc0, lane, sacc[0], sacc[1]);
#pragma unroll
        for (int dir = 0; dir < 2; ++dir)
#pragma unroll
            for (int x = 0; x < 2; ++x) { const int s_ = 16 * (tc0 + x) + cl; const float us = VLI[dir * 64 + s_] - VB[dir * 64 + s_];
#pragma unroll
                for (int i = 0; i < 4; ++i) { const int t = 16 * tr + 4 * q4 + i; const bool ok = dir ? (s_ >= t) : (s_ <= t);
                    st_bf16(Wb + dir * 64 * LP + t * LP + s_, ok ? __expf(VB[dir * 64 + t] + us - MT[dir * 64 + t]) * sacc[x][i] : 0.f); } }
    }
    __syncthreads();
    {
        const int row = tid >> 3, seg = tid & 7; const v4u qq = *(const LAS v4u*)(qb + row * LP + 8 * seg);
#pragma unroll
        for (int dir = 0; dir < 2; ++dir) { const v4u w = *(const LAS v4u*)(Wb + dir * 64 * LP + row * LP + 8 * seg); const LAS float* np = NP + dir * 64 + 8 * seg;
            float dw = ((bflo(w.x) + bfhi(w.x)) + (bflo(w.y) + bfhi(w.y))) + ((bflo(w.z) + bfhi(w.z)) + (bflo(w.w) + bfhi(w.w)));
            float qn = (bflo(qq.x) * np[0] + bfhi(qq.x) * np[1]) + (bflo(qq.y) * np[2] + bfhi(qq.y) * np[3]) + (bflo(qq.z) * np[4] + bfhi(qq.z) * np[5]) + (bflo(qq.w) * np[6] + bfhi(qq.w) * np[7]);
            dw += SHX(dw, 1); dw += SHX(dw, 2); dw += SHX(dw, 4); qn += SHX(qn, 1); qn += SHX(qn, 2); qn += SHX(qn, 4);
            if (seg == 0) INV[dir * 64 + row] = 1.0f / fmaxf(fabsf(dw + SI[dir * 64 + row] * qn), expf(-MT[dir * 64 + row])); }
    }
    f32x4 nw[2][2], in_[2][2];
#pragma unroll
    for (int dir = 0; dir < 2; ++dir) { nw[dir][0] = (f32x4){0.f, 0.f, 0.f, 0.f}; nw[dir][1] = nw[dir][0]; in_[dir][0] = nw[dir][0]; in_[dir][1] = nw[dir][0];
        mm_16x32(Wb + dir * 64 * LP, vT, tr, tc0, lane, nw[dir][0], nw[dir][1]); mm_16x32(qb, CpT + dir * 64 * LP, tr, tc0, lane, in_[dir][0], in_[dir][1]); }
    __syncthreads();
#pragma unroll
    for (int i = 0; i < 4; ++i) { const int t = 16 * tr + 4 * q4 + i; const float si0 = SI[t], inv0 = INV[t], si1 = SI[64 + t], inv1 = INV[64 + t];
#pragma unroll
        for (int x = 0; x < 2; ++x) HB[t * 64 + 16 * (tc0 + x) + cl] = (nw[0][x][i] + si0 * in_[0][x][i]) * inv0 + (nw[1][x][i] + si1 * in_[1][x][i]) * inv1; }
    __syncthreads();
    const int t0 = (tid >> 4) * 2, x0 = (tid & 15) * 4;
    const f32x4 gn = *(const f32x4*)(gnorm + h * 64 + x0);
#pragma unroll
    for (int i = 0; i < 2; ++i) { const f32x4 hv = *(const LAS f32x4*)(HB + (t0 + i) * 64 + x0); float ss = (hv[0] * hv[0] + hv[1] * hv[1]) + (hv[2] * hv[2] + hv[3] * hv[3]);
        ss += SHX(ss, 1); ss += SHX(ss, 2); ss += SHX(ss, 4); ss += SHX(ss, 8);
        const float r = 1.0f / sqrtf(ss * (1.0f / 64.0f) + 1e-6f);
        const v2u og = *(const v2u*)(prow + (size_t)(t0 + i) * NPROJ + P_MLO + h * 64 + x0);
        const float o0 = bflo(og.x), o1 = bfhi(og.x), o2 = bflo(og.y), o3 = bfhi(og.y);
        const float y0 = hv[0] * r * gn[0] / (1.0f + expf(-o0)), y1 = hv[1] * r * gn[1] / (1.0f + expf(-o1)), y2 = hv[2] * r * gn[2] / (1.0f + expf(-o2)), y3 = hv[3] * r * gn[3] / (1.0f + expf(-o3));
        v2u w; w.x = pk2(y0, y1); w.y = pk2(y2, y3); *(v2u*)(YCAT + (size_t)(trow0 + t0 + i) * DM + h * 64 + x0) = w; }
    __syncthreads();
}
__device__ __forceinline__ void diff_combine(const bf16* DQP, const float* lamp, const float* gsub, float lam_init, bf16* YCAT, int gw, int NGW, int lane) {
    float p1 = 0.f, p2 = 0.f; if (lane < 32) { p1 = lamp[lane] * lamp[32 + lane]; p2 = lamp[64 + lane] * lamp[96 + lane]; }
    const float lam = expf(wave_sum(p1)) - expf(wave_sum(p2)) + lam_init;
    const int head = lane >> 4, d4 = (lane & 15) * 4; const f32x4 g = *(const f32x4*)(gsub + d4); const float post = 1.0f - lam_init;
    for (int t = gw; t < MROWS; t += NGW) { const bf16* p = DQP + (size_t)t * 512 + head * 128 + d4; const v2u a = *(const v2u*)p, bq = *(const v2u*)(p + 64);
        const float x0 = bflo(a.x) - lam * bflo(bq.x), x1 = bfhi(a.x) - lam * bfhi(bq.x), x2 = bflo(a.y) - lam * bflo(bq.y), x3 = bfhi(a.y) - lam * bfhi(bq.y);
        float ss = (x0 * x0 + x1 * x1) + (x2 * x2 + x3 * x3); ss += SHX(ss, 1); ss += SHX(ss, 2); ss += SHX(ss, 4); ss += SHX(ss, 8);
        const float r = post / sqrtf(ss * (1.0f / 64.0f) + 1e-6f);
        v2u w; w.x = pk2(x0 * r * g[0], x1 * r * g[1]); w.y = pk2(x2 * r * g[2], x3 * r * g[3]); *(v2u*)(YCAT + (size_t)t * DM + 512 + head * 64 + d4) = w; }
}

typedef const __attribute__((address_space(4))) Args* KArgs;
__device__ __forceinline__ KArgs kargs() { KArgs p = (KArgs)__builtin_amdgcn_kernarg_segment_ptr(); asm volatile("" : "+s"(p)); return p; }
#define WSP(T, off) ((T*)(ws + (off)))
#ifndef REP_VALU
#define REP_VALU 1
#endif
#ifndef REP_ATT
#define REP_ATT 1
#endif
#ifndef REP_GEMM
#define REP_GEMM 1
#endif
#ifndef REP_FFI
#define REP_FFI 1
#endif
#ifndef REP_X
#define REP_X 1
#endif
#ifndef REP_GATES
#define REP_GATES 1
#endif
#ifndef DRY_QK
#define DRY_QK 0
#endif
#ifndef DRY_SCAN
#define DRY_SCAN 0
#endif
#ifndef REP_F
#define REP_F 1
#endif
#ifndef REP_PRO
#define REP_PRO 1
#endif
#define LTID int tid_l; asm volatile("v_mbcnt_lo_u32_b32 %0, -1, 0\n\tv_mbcnt_hi_u32_b32 %0, -1, %0" : "=v"(tid_l)); tid_l += wv * 64; const int tid = tid_l
__global__ void __launch_bounds__(NTHR, 2) hybrid_fwd(Args args_unused) {
    extern __shared__ __attribute__((aligned(16))) unsigned char lds_raw[];
    LAS unsigned char* lds = (LAS unsigned char*)lds_raw;
    const int wv = __builtin_amdgcn_readfirstlane((int)threadIdx.x >> 6);
    const int G = gridDim.x; const int bx = blockIdx.x; const int vcu = (G % 8 == 0) ? (bx % 8) * (G / 8) + bx / 8 : bx;
    { LTID; for (int u = tid; u < (LDS_BYTES - LDSCTL_OFF) / 4; u += NTHR) ((LAS unsigned*)(lds + LDSCTL_OFF))[u] = 0u; }
    __syncthreads();
    XcdBarrier bar; bar.bar = (unsigned*)((gu32*)(kargs()->ws + WS_CTL) + CW_BAR); bar.x = 0u; bar.st = (volatile LAS unsigned*)(lds + MISC_OFF) + 8;
    const int lo = kargs()->ph_lo, hi = kargs()->ph_hi;
#define IN(k) (lo <= (k) && (k) < hi)
#ifndef PHMASK
#define PHMASK 0xFFFF
#endif
#define PHON(k) (((PHMASK) >> (k)) & 1)
#ifndef PROF_SUB
#define PROF_SUB (-1)
#endif
#define SUBT(n) do { if (PROF_SUB >= 0 && l == 0) { __syncthreads(); if (PROF_SUB == (n)) tp0 = __builtin_amdgcn_s_memrealtime(); if (PROF_SUB + 1 == (n)) tp1 = __builtin_amdgcn_s_memrealtime(); } } while (0)
#ifndef PROF_LO
#define PROF_LO (-1)
#define PROF_HI (-1)
#endif
    unsigned long long tp0 = 0ull, tp1 = 0ull;
#define SEAM(k) do { if (IN(k) && IN((k) + 1)) xcd_barrier(bar); if (PROF_LO >= 0) { if ((k) == PROF_LO - 1) tp0 = __builtin_amdgcn_s_memrealtime(); if ((k) == PROF_HI) tp1 = __builtin_amdgcn_s_memrealtime(); } } while (0)
#define WAVE_IDS LTID; const int lane = tid & 63, wave = __builtin_amdgcn_readfirstlane(tid >> 6), gw = vcu * NWAVES + wave, NGW = G * NWAVES; (void)lane; (void)gw; (void)NGW

    if (PHON(12) && IN(0)) { { WAVE_IDS; if (bx == 0) for (int i = tid; i < XCD_BAR_WORDS; i += NTHR) __hip_atomic_store((unsigned*)((gu32*)(kargs()->ws + WS_CTL) + CW_BAR) + i, 0u, __ATOMIC_RELAXED, __HIP_MEMORY_SCOPE_AGENT);
        for (int rep_ = 0; rep_ < REP_PRO; ++rep_) p0_prologue(kargs(), lds, vcu, G, wave, lane, tid); } __threadfence(); cg::this_grid().sync(); }
    bar = xcd_barrier_post((unsigned*)((gu32*)(kargs()->ws + WS_CTL) + CW_BAR), (volatile LAS unsigned*)(lds + MISC_OFF) + 8);

#pragma unroll 1
    for (int l = 0; l < DEPTH; ++l) {
        const int P = 1 + 12 * l;
        if (PHON(0) && IN(P + 0)) {
            { KArgs ap = kargs(); unsigned char* ws = ap->ws; LTID; pg8::GemmK1024 g{WSP(bf16, WS_XB), (const bf16*)(ws + WS_W + (size_t)l * W_LAYER + W_IN)}; pg8::StaticOrder S; S.init(MROWS / 256, 8, G, bx);
              pg8::EpiScaled E{WSP(bf16, WS_PROJ), NPROJ, WSP(float, WS_SSQ), nullptr};
              for (int rep_ = 0; rep_ < REP_GEMM; ++rep_) pg8::gemm_phase<pg8::GemmK1024, pg8::EpiScaled, pg8::StaticOrder, true, true, false>(lds + RING_OFF, g, S, E, tid); }
            { KArgs ap = kargs(); unsigned char* ws = ap->ws; WAVE_IDS; gates_phase(WSP(bf16, WS_XB), WSP(bf16, WS_WG) + (size_t)l * 2 * 16384, WSP(float, WS_SSQ), WSP(float, WS_GATES), gw, NGW, lane); }
        }
        SEAM(P + 0);
        if (PHON(1) && IN(P + 1)) {
            { KArgs ap = kargs(); unsigned char* ws = ap->ws; LTID; pg8::GemmK1024 g{WSP(bf16, WS_XB), (const bf16*)(ws + WS_W + (size_t)l * W_LAYER + W_IN)}; pg8::StaticOrder S; S.init(MROWS / 256, 2, G, bx, 8);
              pg8::EpiScaled E{WSP(bf16, WS_PROJ), NPROJ, WSP(float, WS_SSQ), nullptr};
              pg8::gemm_phase<pg8::GemmK1024, pg8::EpiScaled, pg8::StaticOrder, true, true, false>(lds + RING_OFF, g, S, E, tid); }
            {
                { const int ll = l; KArgs ap = kargs(); unsigned char* ws = ap->ws;
                    LTID; pg8::GemmK1024 g{WSP(bf16, WS_MEMN) + (size_t)ll * 512 * DM, (const bf16*)(ws + WS_W + (size_t)ll * W_LAYER + W_CKV)};
                    pg8::StaticOrder S; S.init(2, 8, G, (bx + G - 128) % G); pg8::EpiF32 E{WSP(float, WS_KVRAW) + (size_t)ll * 512 * 2048, 2048};
                    pg8::gemm_phase<pg8::GemmK1024, pg8::EpiF32, pg8::StaticOrder, true, true, false>(lds + RING_OFF, g, S, E, tid); }
            }
            int first, count, stride;
            if (G == 256) { if (bx < 144) { first = bx * 3; count = 3; } else { const int j = bx - 144; first = 432 + 5 * j + (j < 32 ? j : 32); count = 5 + (j < 32 ? 1 : 0); } stride = 1; } else { first = bx; count = (1024 - bx + G - 1) / G; stride = G; }
            { KArgs ap = kargs(); unsigned char* ws = ap->ws; WAVE_IDS;
              { bf16* PROJ = WSP(bf16, WS_PROJ); bf16* DQP = WSP(bf16, WS_DQP); const float2* RT = WSP(const float2, WS_ROPE);
                for (int j = 0; j < count; ++j) { const int t0 = (first + j * stride) * 16 + wave * 2; QKRaw w[2];
#pragma unroll
                    for (int u = 0; u < 2; ++u) qk_load<true, false>(t0 + u, PROJ, RT, lane, w[u]);
#pragma unroll
                    for (int u = 0; u < 2; ++u) qk_finish<true, false>(t0 + u, PROJ, DQP, ap->in[9] + l * 32, ap->in[10] + l * 32, ap->in[13] + l * 64, ap->in[14] + l * 64, lane, w[u]); } }
 }
            { KArgs ap = kargs(); unsigned char* ws = ap->ws; float* GG = WSP(float, WS_MLSC); LTID;
              for (int j = 0; j < count; ++j) ml_local_item(lds + RING_OFF, first + j * stride, WSP(bf16, WS_PROJ), WSP(float, WS_GATES), ap->in[4] + l * 8, ap->in[5] + l * 8, ap->out, WSP(float, WS_NLOC), GG, GG + 2048, tid); }
            { KArgs ap = kargs(); unsigned char* ws = ap->ws; LTID;
              for (int j = 0; j < count; ++j) pool_item(lds + RING_OFF, first + j * stride, WSP(bf16, WS_PROJ), ap->in[7] + (size_t)l * 16384, ap->in[8] + l * 256, WSP(bf16, WS_YCAT), tid); }
        }
        SEAM(P + 1);
        if (PHON(2) && IN(P + 2)) { KArgs ap = kargs(); unsigned char* ws = ap->ws; WAVE_IDS; float* GG = WSP(float, WS_MLSC);
            for (int idx = l * 512 + gw; idx < (l + 1) * 512; idx += NGW) mem_post_row(idx, WSP(float, WS_KVRAW), ap->in[20], ap->in[21], WSP(bf16, WS_KM), WSP(bf16, WS_VMT), lane);
            { bf16* PROJ = WSP(bf16, WS_PROJ); const float2* RT = WSP(const float2, WS_ROPE);
              int qw = gw, qn = NGW; if (NGW > 16 * 65) { if (l + 1 < DEPTH) { qw = gw; qn = 16 * 65; if (gw >= 16 * 65) qw = MROWS; } else { qw = gw - 16 * 65; qn = NGW - 16 * 65; if (gw < 16 * 65) qw = MROWS; } }
              for (int t0 = qw * 2; t0 < MROWS; t0 += qn * 2) { QKRaw w[2];
#pragma unroll
                  for (int u = 0; u < 2; ++u) qk_load<false, true>(t0 + u, PROJ, RT, lane, w[u]);
#pragma unroll
                  for (int u = 0; u < 2; ++u) qk_finish<false, true>(t0 + u, PROJ, nullptr, ap->in[9] + l * 32, ap->in[10] + l * 32, ap->in[13] + l * 64, ap->in[14] + l * 64, lane, w[u]); } }
            ml_scan(ap->out, WSP(float, WS_NLOC), GG, GG + 2048, GG + 4096, gw, NGW, lane);
            if (l + 1 < DEPTH) { if (NGW > 16 * 65) { constexpr int CUT = (CONV_ITEMS * 7) / 8;
                    if (gw >= 16 * 65) convert_weights(ap, lds, l + 1, gw - 16 * 65, NGW - 16 * 65, wave, lane, 0, CUT, true); else convert_weights(ap, lds, l + 1, gw, 16 * 65, wave, lane, CUT, CONV_ITEMS, false); }
                else convert_weights(ap, lds, l + 1, gw, NGW, wave, lane, 0, CONV_ITEMS, true); } }
        SEAM(P + 2);
        if (PHON(3) && IN(P + 3)) {
#pragma unroll 1
            for (int u = vcu; u < 256; u += G) {
                KArgs ap = kargs(); unsigned char* ws = ap->ws; LTID; bf16* PROJ = WSP(bf16, WS_PROJ); bf16* DQP = WSP(bf16, WS_DQP); bf16* YCAT = WSP(bf16, WS_YCAT);
                const int b = u >> 7, hh = (u >> 5) & 3, qb = u & 31; const size_t r0 = (size_t)b * SEQ, rq = r0 + (size_t)qb * 256;
                const float lam_init = 0.8f - 0.6f * expf(-0.3f * (float)l); const float* lamp = ap->in[11] + l * 128; const int lane = tid & 63;
                float p1 = 0.f, p2 = 0.f; if (lane < 32) { p1 = lamp[lane] * lamp[32 + lane]; p2 = lamp[64 + lane] * lamp[96 + lane]; }
                const float lam = expf(wave_sum(p1)) - expf(wave_sum(p2)) + lam_init;
                attn_body::attn_unit<8, 0>((const attn_body::bf16*)(PROJ + rq * NPROJ + P_GQ + hh * 64), NPROJ, (const attn_body::bf16*)(PROJ + r0 * NPROJ + P_GK + (hh >> 1) * 64), (const attn_body::bf16*)(PROJ + r0 * NPROJ + P_GV + (hh >> 1) * 64),
                                           (attn_body::bf16*)(YCAT + rq * DM + 768 + hh * 64), DM, (char*)lds_raw + RING_OFF, tid, 0.f, 0.f, nullptr);
                attn_body::attn_unit<8, 1>((const attn_body::bf16*)(DQP + rq * 512 + (2 * hh) * 64), 512, (const attn_body::bf16*)(PROJ + r0 * NPROJ + P_DK + hh * 64), (const attn_body::bf16*)(PROJ + r0 * NPROJ + P_DV + hh * 64),
                                           (attn_body::bf16*)nullptr, 0, (char*)lds_raw + RING_OFF, tid, 0.f, 0.f, nullptr);
                attn_body::attn_unit<8, 2>((const attn_body::bf16*)(DQP + rq * 512 + (2 * hh + 1) * 64), 512, (const attn_body::bf16*)(PROJ + r0 * NPROJ + P_DK + hh * 64), (const attn_body::bf16*)(PROJ + r0 * NPROJ + P_DV + hh * 64),
                                           (attn_body::bf16*)(YCAT + rq * DM + 512 + hh * 64), DM, (char*)lds_raw + RING_OFF, tid, lam, 1.0f - lam_init, ap->in[12] + l * 64);
            }
            { KArgs ap = kargs(); unsigned char* ws = ap->ws; float* GG = WSP(float, WS_MLSC); LTID;
              for (int it = vcu; it < 1024; it += G) ml_out_item(lds + RING_OFF, it, WSP(bf16, WS_PROJ), WSP(float, WS_GATES), ap->in[4] + l * 8, ap->in[5] + l * 8, ap->out, WSP(float, WS_NLOC), GG + 4096, ap->in[6] + l * 256, WSP(bf16, WS_YCAT), tid); }
        }
        SEAM(P + 3);
        if (PHON(5) && IN(P + 5)) { KArgs ap = kargs(); unsigned char* ws = ap->ws; const float* xin = (l == 0) ? ap->in[0] : (const float*)nullptr;
            LTID; pg8::GemmK1024 g{WSP(bf16, WS_YCAT), (const bf16*)(ws + WS_W + (size_t)l * W_LAYER + W_OUT)}; pg8::StaticOrder S; S.init(MROWS / 256, 4, G, bx);
            pg8::EpiRes E{xin, nullptr, WSP(bf16, WS_XB), WSP(float, WS_SSQ)}; for (int rep_ = 0; rep_ < ((l == 0) ? REP_F : 1); ++rep_) pg8::gemm_phase<pg8::GemmK1024, pg8::EpiRes, pg8::StaticOrder, true, true, false>(lds + RING_OFF, g, S, E, tid); }
        SEAM(P + 5);
        if (PHON(6) && IN(P + 6)) { KArgs ap = kargs(); unsigned char* ws = ap->ws; LTID; pg8::GemmK1024 g{WSP(bf16, WS_XB), (const bf16*)(ws + WS_W + (size_t)l * W_LAYER + W_CQ)}; pg8::StaticOrder S; S.init(MROWS / 256, 4, G, bx);
            pg8::EpiScaled E{WSP(bf16, WS_CQ), DM, WSP(float, WS_SSQ), WSP(float, WS_HSSQ)}; for (int rep_ = 0; rep_ < REP_GEMM; ++rep_) pg8::gemm_phase<pg8::GemmK1024, pg8::EpiScaled, pg8::StaticOrder, true, true, false>(lds + RING_OFF, g, S, E, tid); }
        if (PHON(7) && IN(P + 7)) { KArgs ap = kargs(); unsigned char* ws = ap->ws; LTID; pg8::GemmHeads g{WSP(bf16, WS_CQ), WSP(bf16, WS_KM) + (size_t)l * 8 * 65536};
            pg8::StaticOrder S; S.init(MROWS / 256, 4, G, bx); pg8::EpiScore E{WSP(bf16, WS_PT), WSP(float, WS_HSSQ), WSP(float, WS_PSUM)};
            for (int rep_ = 0; rep_ < REP_X; ++rep_) pg8::gemm_phase<pg8::GemmHeads, pg8::EpiScore, pg8::StaticOrder, true, true, false>(lds + RING_OFF, g, S, E, tid); }
        if (PHON(8) && IN(P + 8)) { KArgs ap = kargs(); unsigned char* ws = ap->ws; LTID; pg8::GemmHeads g{WSP(bf16, WS_PT), WSP(bf16, WS_VMT) + (size_t)l * 8 * 65536};
            pg8::StaticOrder S; S.init(MROWS / 256, 4, G, bx); pg8::EpiPV E{WSP(bf16, WS_CO), WSP(float, WS_PSUM)};
            for (int rep_ = 0; rep_ < REP_X; ++rep_) pg8::gemm_phase<pg8::GemmHeads, pg8::EpiPV, pg8::StaticOrder, true, true, false>(lds + RING_OFF, g, S, E, tid); }
        SEAM(P + 8);
        if (PHON(9) && IN(P + 9)) { KArgs ap = kargs(); unsigned char* ws = ap->ws; LTID; pg8::GemmK1024 g{WSP(bf16, WS_CO), (const bf16*)(ws + WS_W + (size_t)l * W_LAYER + W_CO)}; pg8::StaticOrder S; S.init(MROWS / 256, 4, G, bx);
            pg8::EpiRes E{nullptr, nullptr, WSP(bf16, WS_XB), WSP(float, WS_SSQ)}; pg8::gemm_phase<pg8::GemmK1024, pg8::EpiRes, pg8::StaticOrder, true, true, false>(lds + RING_OFF, g, S, E, tid); }
        SEAM(P + 9);
        if (PHON(10) && IN(P + 10)) { KArgs ap = kargs(); unsigned char* ws = ap->ws; LTID; pg8::GemmConv g{WSP(bf16, WS_XB) - DM, (const bf16*)(ws + WS_W + (size_t)l * W_LAYER + W_FI)};
            pg8::StaticOrder S; S.init(67, NFF / 256, G, bx); pg8::EpiFFN E{WSP(bf16, WS_ACT), WSP(float, WS_SSQ), ap->in[25] + (size_t)l * 3 * DFF, ap->in[26] + (size_t)l * DFF, MROWS};
            for (int rep_ = 0; rep_ < REP_FFI; ++rep_) pg8::gemm_phase<pg8::GemmConv, pg8::EpiFFN, pg8::StaticOrder, true, true, true>(lds + RING_OFF, g, S, E, tid); }
        SEAM(P + 10);
        if (PHON(11) && IN(P + 11)) { KArgs ap = kargs(); unsigned char* ws = ap->ws; LTID; pg8::GemmK2816 g{WSP(bf16, WS_ACT), (const bf16*)(ws + WS_W + (size_t)l * W_LAYER + W_FO)}; pg8::StaticOrder S; S.init(MROWS / 256, 4, G, bx);
            pg8::EpiRes E{nullptr, (l == DEPTH - 1) ? ap->out : (float*)nullptr, WSP(bf16, WS_XB), WSP(float, WS_SSQ)}; pg8::gemm_phase<pg8::GemmK2816, pg8::EpiRes, pg8::StaticOrder, true, true, false>(lds + RING_OFF, g, S, E, tid); }
        SEAM(P + 11);
    }
    if ((PROF_LO >= 0 || PROF_SUB >= 0) && bx == 0) { const unsigned long long t_end = __builtin_amdgcn_s_memrealtime() + 9ull * (tp1 - tp0); while (__builtin_amdgcn_s_memrealtime() < t_end) __builtin_amdgcn_s_sleep(8); }
#undef IN
#undef SEAM
}

#ifndef MK_CUTS
#define MK_CUTS 0
#endif
extern "C" void kernel_launch(void* const* d_in, const int* in_sizes, int n_in, void* d_out, int out_size, void* d_ws, size_t ws_size, hipStream_t stream) {
    static int grid = 0;
    if (grid == 0) {
        if (n_in != 28 || out_size != MROWS * DM || ws_size < WS_END) { fprintf(stderr, "kernel_launch: unexpected shapes (n_in %d, out %d, ws %zu)\n", n_in, out_size, ws_size); grid = -1; return; }
        int dev = 0, cus = 0, per_cu = 0;
        hipGetDevice(&dev); hipDeviceGetAttribute(&cus, hipDeviceAttributeMultiprocessorCount, dev);
        if (hipFuncSetAttribute((const void*)hybrid_fwd, hipFuncAttributeMaxDynamicSharedMemorySize, LDS_BYTES) != hipSuccess) { fprintf(stderr, "kernel_launch: hipFuncSetAttribute failed\n"); grid = -1; return; }
        if (hipOccupancyMaxActiveBlocksPerMultiprocessor(&per_cu, (const void*)hybrid_fwd, NTHR, LDS_BYTES) != hipSuccess || per_cu < 1) { fprintf(stderr, "kernel_launch: occupancy query says %d\n", per_cu); per_cu = 1; }
        (void)hipGetLastError();
        grid = cus;
    }
    if (grid < 0) return;
    Args a{};
    for (int i = 0; i < 28; ++i) a.in[i] = (const float*)d_in[i];
    a.out = (float*)d_out; a.ws = (unsigned char*)d_ws;
    constexpr int NPH = 1 + 12 * DEPTH;
#if MK_CUTS
    for (int p = 0; p < NPH; ++p) { a.ph_lo = p; a.ph_hi = p + 1; void* kargs[] = {&a};
        hipError_t e = hipLaunchCooperativeKernel((const void*)hybrid_fwd, dim3(grid), dim3(NTHR), kargs, LDS_BYTES, stream);
        if (e != hipSuccess) { fprintf(stderr, "launch %d failed: %s\n", p, hipGetErrorString(e)); break; } }
#else
    a.ph_lo = 0; a.ph_hi = NPH; void* kargs[] = {&a};
    hipError_t e = hipLaunchCooperativeKernel((const void*)hybrid_fwd, dim3(grid), dim3(NTHR), kargs, LDS_BYTES, stream);
    if (e != hipSuccess) fprintf(stderr, "cooperative launch failed: %s (grid %d)\n", hipGetErrorString(e), grid);
#endif
}
```
